# Optimizing an MI355X kernel written in HIP

```python
import jax, jax.numpy as jnp
from jax import lax
import numpy as np

D_MODEL = 4096
BATCH = 8
SEQ = 2048
DEPTH = 1
DEC_BATCH = 2
DEC_SEQ = 8192
PAST_LEN = 128

PLE_DIM = 256
D_FF = 11008
CHUNK = 128
GM_GROUPS = 16
GM_GROUP_DIM = 128
GM_WIDTH = GM_GROUPS * GM_GROUP_DIM
MLA_HEADS = 16
QK_NOPE_DIM = 128
QK_ROPE_DIM = 64
V_HEAD_DIM = 128
Q_LORA_RANK = 1024
KV_LORA_RANK = 512
ROPE_THETA = 10000.0
Q_BLOCK = 128
RMS_EPS = 1e-6
IN_WIDTH = 2 * GM_WIDTH + Q_LORA_RANK + KV_LORA_RANK + QK_ROPE_DIM + 2 * D_MODEL

kernel_name = "hybrid_gmlp_mla_macaron_encoder"


def rmsnorm(x, g):
    xf = x.astype(jnp.float32)
    y = xf * lax.rsqrt(jnp.mean(xf * xf, axis=-1, keepdims=True) + RMS_EPS)
    return (y * g.astype(jnp.float32)).astype(x.dtype)


def swiglu(h, wg, wu, wd):
    return (jax.nn.silu(h @ wg) * (h @ wu)) @ wd


def rope_tables(S, dtype):
    inv = 1.0 / (ROPE_THETA ** (jnp.arange(0, QK_ROPE_DIM, 2, dtype=jnp.float32) / QK_ROPE_DIM))
    ang = jnp.arange(S, dtype=jnp.float32)[:, None] * inv[None, :]
    return jnp.cos(ang).astype(dtype), jnp.sin(ang).astype(dtype)


def apply_rope(x, cos, sin):
    half = QK_ROPE_DIM // 2
    x1, x2 = x[..., :half], x[..., half:]
    return jnp.concatenate([x1 * cos - x2 * sin, x1 * sin + x2 * cos], axis=-1)


def gmlp_mixer(u, v, v_norm, ws, bs):
    B, S, _ = v.shape
    u = jax.nn.gelu(u)
    v = rmsnorm(jax.nn.gelu(v), v_norm)
    vc = v.reshape(B, S // CHUNK, CHUNK, GM_GROUPS, GM_GROUP_DIM)
    mixed = jnp.einsum('gpq,bnqgc->bnpgc', ws, vc) + bs.T[None, None, :, :, None]
    return u * mixed.reshape(B, S, GM_WIDTH)


def mla_mixer(q_lat, kv_lat, k_rope, q_norm, w_uq, kv_norm, w_ukv):
    B, S, _ = q_lat.shape
    H = MLA_HEADS
    q = (rmsnorm(q_lat, q_norm) @ w_uq).reshape(B, S, H, QK_NOPE_DIM + QK_ROPE_DIM)
    q_nope, q_rope = q[..., :QK_NOPE_DIM], q[..., QK_NOPE_DIM:]
    kv = (rmsnorm(kv_lat, kv_norm) @ w_ukv).reshape(B, S, H, QK_NOPE_DIM + V_HEAD_DIM)
    k_nope, v = kv[..., :QK_NOPE_DIM], kv[..., QK_NOPE_DIM:]
    cos, sin = rope_tables(S, q.dtype)
    q_rope = apply_rope(q_rope, cos[:, None, :], sin[:, None, :])
    k_rope = apply_rope(k_rope, cos, sin)
    scale = (QK_NOPE_DIM + QK_ROPE_DIM) ** -0.5
    nb = S // Q_BLOCK
    qn_b = q_nope.reshape(B, nb, Q_BLOCK, H, QK_NOPE_DIM).transpose(1, 0, 2, 3, 4)
    qr_b = q_rope.reshape(B, nb, Q_BLOCK, H, QK_ROPE_DIM).transpose(1, 0, 2, 3, 4)

    def attend(blk):
        qn, qr = blk
        s = jnp.einsum('bqhd,bkhd->bhqk', qn, k_nope) + jnp.einsum('bqhr,bkr->bhqk', qr, k_rope)
        pr = jax.nn.softmax(s.astype(jnp.float32) * scale, axis=-1).astype(v.dtype)
        return jnp.einsum('bhqk,bkhd->bqhd', pr, v)

    o = lax.map(attend, (qn_b, qr_b))
    return o.transpose(1, 0, 2, 3, 4).reshape(B, S, H * V_HEAD_DIM)


def encoder_layer(x, p, ffn1_norm, ffn1_wg, ffn1_wu, ffn1_wd, mix_norm, w_in, gm_v_norm, gm_ws, gm_bs,
                  w_out_a, q_norm, w_uq, kv_norm, w_ukv, w_out_b, w_out, ffn2_norm, ffn2_wg, ffn2_wu,
                  ffn2_wd, ple_gate_norm, w_ple_gate, w_ple_proj, ple_post_norm):
    x = x + 0.5 * swiglu(rmsnorm(x, ffn1_norm), ffn1_wg, ffn1_wu, ffn1_wd)
    z = rmsnorm(x, mix_norm) @ w_in
    widths = [GM_WIDTH, GM_WIDTH, Q_LORA_RANK, KV_LORA_RANK, QK_ROPE_DIM, D_MODEL]
    offs = [int(o) for o in np.cumsum(widths)]
    u, v, q_lat, kv_lat, k_rope, gate_a, gate_b = jnp.split(z, offs, axis=-1)
    y_a = gmlp_mixer(u, v, gm_v_norm, gm_ws, gm_bs) @ w_out_a
    y_b = mla_mixer(q_lat, kv_lat, k_rope, q_norm, w_uq, kv_norm, w_ukv) @ w_out_b
    merged = jax.nn.sigmoid(gate_a) * y_a + jax.nn.sigmoid(gate_b) * y_b
    x = x + merged @ w_out
    x = x + 0.5 * swiglu(rmsnorm(x, ffn2_norm), ffn2_wg, ffn2_wu, ffn2_wd)
    g = jax.nn.sigmoid(rmsnorm(x, ple_gate_norm) @ w_ple_gate)
    x = x + rmsnorm(g * (p @ w_ple_proj), ple_post_norm)
    return x


def setup_inputs(seed: int = 0) -> dict:
    key = jax.random.key(seed)
    ks = iter(jax.random.split(key, 40))
    L, D = DEPTH, D_MODEL

    def dense(shape, fan_in):
        return jax.random.normal(next(ks), shape, jnp.float32) * (fan_in ** -0.5)

    def gain(shape):
        return 1.0 + 0.01 * jax.random.normal(next(ks), shape, jnp.float32)

    return {
        "x_prompt": jax.random.normal(next(ks), (BATCH, SEQ, D), jnp.float32),
        "x_sample": jax.random.normal(next(ks), (DEC_BATCH, DEC_SEQ, D), jnp.float32),
        "p_prompt": jax.random.normal(next(ks), (DEPTH, BATCH, SEQ, PLE_DIM), jnp.float32),
        "p_sample": jax.random.normal(next(ks), (DEPTH, DEC_BATCH, DEC_SEQ, PLE_DIM), jnp.float32),
        "ffn1_norm": gain((L, D)),
        "ffn1_wg": dense((L, D, D_FF), D),
        "ffn1_wu": dense((L, D, D_FF), D),
        "ffn1_wd": dense((L, D_FF, D), D_FF),
        "mix_norm": gain((L, D)),
        "w_in": dense((L, D, IN_WIDTH), D),
        "gm_v_norm": gain((L, GM_WIDTH)),
        "gm_ws": dense((L, GM_GROUPS, CHUNK, CHUNK), CHUNK),
        "gm_bs": 1.0 + 0.1 * jax.random.normal(next(ks), (L, GM_GROUPS, CHUNK), jnp.float32),
        "w_out_a": dense((L, GM_WIDTH, D), GM_WIDTH),
        "q_norm": gain((L, Q_LORA_RANK)),
        "w_uq": dense((L, Q_LORA_RANK, MLA_HEADS * (QK_NOPE_DIM + QK_ROPE_DIM)), Q_LORA_RANK),
        "kv_norm": gain((L, KV_LORA_RANK)),
        "w_ukv": dense((L, KV_LORA_RANK, MLA_HEADS * (QK_NOPE_DIM + V_HEAD_DIM)), KV_LORA_RANK),
        "w_out_b": dense((L, MLA_HEADS * V_HEAD_DIM, D), MLA_HEADS * V_HEAD_DIM),
        "w_out": dense((L, D, D), D),
        "ffn2_norm": gain((L, D)),
        "ffn2_wg": dense((L, D, D_FF), D),
        "ffn2_wu": dense((L, D, D_FF), D),
        "ffn2_wd": dense((L, D_FF, D), D_FF),
        "ple_gate_norm": gain((L, D)),
        "w_ple_gate": dense((L, D, D), D),
        "w_ple_proj": dense((L, PLE_DIM, D), PLE_DIM),
        "ple_post_norm": gain((L, D)),
        "final_norm": gain((D,)),
    }


def reference(x_prompt, x_sample, p_prompt, p_sample, ffn1_norm, ffn1_wg, ffn1_wu, ffn1_wd, mix_norm, w_in,
              gm_v_norm, gm_ws, gm_bs, w_out_a, q_norm, w_uq, kv_norm, w_ukv, w_out_b, w_out, ffn2_norm,
              ffn2_wg, ffn2_wu, ffn2_wd, ple_gate_norm, w_ple_gate, w_ple_proj, ple_post_norm, final_norm):
    layer_w = (ffn1_norm, ffn1_wg, ffn1_wu, ffn1_wd, mix_norm, w_in, gm_v_norm, gm_ws, gm_bs, w_out_a,
               q_norm, w_uq, kv_norm, w_ukv, w_out_b, w_out, ffn2_norm, ffn2_wg, ffn2_wu, ffn2_wd,
               ple_gate_norm, w_ple_gate, w_ple_proj, ple_post_norm)

    def trunk(x, p):
        for l in range(DEPTH):
            x = encoder_layer(x, p[l], *[w[l] for w in layer_w])
        return rmsnorm(x, final_norm)

    y_prompt = trunk(x_prompt, p_prompt)
    y_sample = trunk(x_sample, p_sample)
    return (y_prompt, y_sample)
```

```cpp
#include <hip/hip_runtime.h>
#include <cstdio>
#include <cstdint>


namespace pg8 {
#define PG8_LAS __attribute__((address_space(3)))
#define PG8_GAS __attribute__((address_space(1)))
typedef unsigned short bf16_t;
typedef short bf16x8 __attribute__((ext_vector_type(8)));
typedef float f32x4 __attribute__((ext_vector_type(4)));
typedef unsigned u32x4 __attribute__((ext_vector_type(4)));
typedef unsigned u32x2 __attribute__((ext_vector_type(2)));
constexpr int RS_OFF = 133120;
constexpr int BM = 256, BK = 64, HALF = 128, HTB = HALF * BK * 2  , STAGE_BYTES = 8 * HTB, NXCD = 8, WGM = 8;

__host__ __device__ __forceinline__ int lds_byte(int r, int c) { const int st = (r >> 4) * 2 + (c >> 5), rr = r & 15, cc = c & 31, ob = rr * 64 + cc * 2; return st * 1024 + (ob ^ (((ob >> 9) & 1) << 5)); }
__host__ __device__ __forceinline__ void stage_rc(int b, int& R, int& C) { const int st = b / 1024, sb = b % 1024, swz = sb ^ (((sb >> 9) & 1) << 5); R = (st >> 1) * 16 + swz / 64; C = (st & 1) * 32 + (swz % 64) / 2; }
__host__ __device__ __forceinline__ int perm32(int rho) { const int n = rho >> 4, i = rho & 15; return 8 * (i >> 2) + 4 * n + (i & 3); }

struct Unit { int pm, pn; };
struct Gemm { const PG8_GAS bf16_t* A; const PG8_GAS bf16_t* Bt; int M, N, K; };

struct StaticOrder {
    int nM, nN, nwg, G, c, wgm;
    __host__ __device__ void init(int M, int N, int G_, int c_, int wgm_ = WGM) { nM = M / BM; nN = N / BM; nwg = nM * nN; G = G_; c = c_; wgm = wgm_; }
    __host__ __device__ bool next(int i, Unit& u) const {
        const long L = (long)i * G + c; if (L >= nwg) return false;
        int wgid = (int)L; { const int q = nwg / NXCD, r = nwg % NXCD, xcd = wgid % NXCD, off = wgid / NXCD; wgid = (xcd < r ? xcd * (q + 1) : r * (q + 1) + (xcd - r) * q) + off; }
        const int nig = wgm * nN, gid = wgid / nig, fm = gid * wgm, gsz = (nM - fm) < wgm ? (nM - fm) : wgm;
        u.pm = fm + ((wgid % nig) % gsz); u.pn = (wgid % nig) / gsz; return true;
    }
    __device__ __forceinline__ void a_ready(const Unit&) const {}
    __device__ __forceinline__ void done(const Unit&) const {}
};

__device__ __forceinline__ unsigned cvt_pk_bf16(float lo, float hi) { unsigned r; asm volatile("s_nop 1\n\tv_cvt_pk_bf16_f32 %0, %1, %2" : "=v"(r) : "v"(lo), "v"(hi)); return r; }
__device__ __forceinline__ u32x4 pack8(const f32x4 a, const f32x4 b) { u32x4 w; w.x = cvt_pk_bf16(a[0], a[1]); w.y = cvt_pk_bf16(a[2], a[3]); w.z = cvt_pk_bf16(b[0], b[1]); w.w = cvt_pk_bf16(b[2], b[3]); return w; }
__device__ __forceinline__ float bf_lo(unsigned w) { return __uint_as_float(w << 16); }
__device__ __forceinline__ float bf_hi(unsigned w) { return __uint_as_float(w & 0xffff0000u); }
__device__ __forceinline__ void unpack8(const u32x4 w, f32x4& a, f32x4& b) { a = (f32x4){bf_lo(w.x), bf_hi(w.x), bf_lo(w.y), bf_hi(w.y)}; b = (f32x4){bf_lo(w.z), bf_hi(w.z), bf_lo(w.w), bf_hi(w.w)}; }
__device__ __forceinline__ float sigmoid_f(float x) { return __builtin_amdgcn_rcpf(1.0f + __builtin_amdgcn_exp2f(-1.4426950408889634f * x)); }
__device__ __forceinline__ float silu_f(float x) { return x * sigmoid_f(x); }
__device__ __forceinline__ float gelu_tanh_f(float x) { const float y = 1.5957691216057308f * (x + 0.044715f * x * x * x); return x * sigmoid_f(y); }
__device__ __forceinline__ f32x4 sigmoid4(const f32x4 v) { return (f32x4){sigmoid_f(v[0]), sigmoid_f(v[1]), sigmoid_f(v[2]), sigmoid_f(v[3])}; }
__device__ __forceinline__ f32x4 gelu4(const f32x4 v) { return (f32x4){gelu_tanh_f(v[0]), gelu_tanh_f(v[1]), gelu_tanh_f(v[2]), gelu_tanh_f(v[3])}; }

__device__ __forceinline__ float ssq44(const f32x4 a, const f32x4 b) { return ((a[0] * a[0] + a[1] * a[1]) + (a[2] * a[2] + a[3] * a[3])) + ((b[0] * b[0] + b[1] * b[1]) + (b[2] * b[2] + b[3] * b[3])); }
__device__ __forceinline__ float row4_sum(float s) {
    s += __int_as_float(__builtin_amdgcn_ds_swizzle(__float_as_int(s), (16 << 10) | 0x1f));
    auto rr = __builtin_amdgcn_permlane32_swap(__float_as_uint(s), __float_as_uint(s), false, false); return __uint_as_float(rr[0]) + __uint_as_float(rr[1]); }
__device__ __forceinline__ float rstd_from_ss(float ss, float inv_n) { return __builtin_amdgcn_rsqf(ss * inv_n + 1e-6f); }
__device__ __forceinline__ void atomic_add_row(PG8_GAS float* p, float v) { asm volatile("global_atomic_add_f32 %0, %1, off sc1" :: "v"(p), "v"(v) : "memory"); }
struct EpiSwiGLU {
    static constexpr bool PERM = true, AFTER_DRAIN = false, ROWSCALE = true; static constexpr float INV_N = 1.f / 4096;
    PG8_GAS bf16_t* H; int ldh; const PG8_GAS float* SX;
    __device__ __forceinline__ void operator()(const f32x4 (&acc)[2][2][4][2], const Unit& u, int wr, int wc, int fr, int fq, const PG8_LAS float* rsl) const {
        const int row0 = u.pm * BM + wr * 64 + fr, col0 = u.pn * HALF + wc * 32 + 8 * fq;
#pragma unroll
        for (int ai = 0; ai < 2; ++ai)
#pragma unroll
            for (int m = 0; m < 4; ++m) { const int row = row0 + ai * HALF + m * 16; const float r = rsl[ai * 64 + m * 16 + fr];
                PG8_GAS bf16_t* rowp = H + (size_t)row * ldh + col0;
                const f32x4 g0 = acc[ai][0][m][0] * r, g1 = acc[ai][0][m][1] * r, u0 = acc[ai][1][m][0] * r, u1 = acc[ai][1][m][1] * r;
                const f32x4 v0 = (f32x4){silu_f(g0[0]) * u0[0], silu_f(g0[1]) * u0[1], silu_f(g0[2]) * u0[2], silu_f(g0[3]) * u0[3]};
                const f32x4 v1 = (f32x4){silu_f(g1[0]) * u1[0], silu_f(g1[1]) * u1[1], silu_f(g1[2]) * u1[2], silu_f(g1[3]) * u1[3]};
                *(PG8_GAS u32x4*)rowp = pack8(v0, v1);
            }
    }
};
struct EpiZ {
    static constexpr bool PERM = true, AFTER_DRAIN = false, ROWSCALE = true; static constexpr float INV_N = 1.f / 4096;
    PG8_GAS bf16_t *GU, *GV, *QL, *KVL, *KR, *GA, *GB; const PG8_GAS float* cs; const PG8_GAS float* sn; int smask; PG8_GAS float* SS; const PG8_GAS float* SX;
    __device__ __forceinline__ void operator()(const f32x4 (&acc)[2][2][4][2], const Unit& u, int wr, int wc, int fr, int fq, const PG8_LAS float* rsl) const {
        const int pn = u.pn, row0 = u.pm * BM + wr * 64 + fr, cw = wc * 32 + 8 * fq;
        if (pn < 16) {
            PG8_GAS bf16_t* dst = (pn < 8 ? GU : GV) + (pn & 7) * BM + cw;
#pragma unroll
            for (int ai = 0; ai < 2; ++ai)
#pragma unroll
                for (int m = 0; m < 4; ++m) { const int row = row0 + ai * HALF + m * 16; PG8_GAS bf16_t* rowp = dst + (size_t)row * 2048; float s = 0.f; const float r = rsl[ai * 64 + m * 16 + fr];
#pragma unroll
                    for (int bj = 0; bj < 2; ++bj) { const f32x4 t0 = gelu4(acc[ai][bj][m][0] * r), t1 = gelu4(acc[ai][bj][m][1] * r); s += ssq44(t0, t1); *(PG8_GAS u32x4*)(rowp + bj * HALF) = pack8(t0, t1); }
                    if (pn >= 8) { s = row4_sum(s); if (fq == 0) atomic_add_row(SS + row, s); } }
        } else if (pn < 22) {
            const bool isq = pn < 20; PG8_GAS bf16_t* dst = isq ? QL + (pn - 16) * BM + cw : KVL + (pn - 20) * BM + cw; const int ld = isq ? 1024 : 512;
#pragma unroll
            for (int ai = 0; ai < 2; ++ai)
#pragma unroll
                for (int m = 0; m < 4; ++m) { const int row = row0 + ai * HALF + m * 16; PG8_GAS bf16_t* rowp = dst + (size_t)row * ld; float s = 0.f; const float r = rsl[ai * 64 + m * 16 + fr];
#pragma unroll
                    for (int bj = 0; bj < 2; ++bj) { const f32x4 t0 = acc[ai][bj][m][0] * r, t1 = acc[ai][bj][m][1] * r; s += ssq44(t0, t1); *(PG8_GAS u32x4*)(rowp + bj * HALF) = pack8(t0, t1); }
                    s = row4_sum(s); if (fq == 0) atomic_add_row(SS + (isq ? 16384 : 32768) + row, s); }
        } else if (pn == 22) {
            if (wc == 0) {
#pragma unroll
                for (int ai = 0; ai < 2; ++ai)
#pragma unroll
                    for (int m = 0; m < 4; ++m) { const int row = row0 + ai * HALF + m * 16, s = row & smask;
                        const f32x4 c0 = *(const PG8_GAS f32x4*)(cs + (size_t)s * 32 + 8 * fq), c1 = *(const PG8_GAS f32x4*)(cs + (size_t)s * 32 + 8 * fq + 4);
                        const f32x4 s0 = *(const PG8_GAS f32x4*)(sn + (size_t)s * 32 + 8 * fq), s1 = *(const PG8_GAS f32x4*)(sn + (size_t)s * 32 + 8 * fq + 4);
                        const float r = rsl[ai * 64 + m * 16 + fr];
                        const f32x4 xa = acc[ai][0][m][0] * r, xb = acc[ai][0][m][1] * r, ya = acc[ai][1][m][0] * r, yb = acc[ai][1][m][1] * r;
                        PG8_GAS bf16_t* rowp = KR + (size_t)row * 64 + 8 * fq;
                        *(PG8_GAS u32x4*)rowp = pack8(xa * c0 - ya * s0, xb * c1 - yb * s1);
                        *(PG8_GAS u32x4*)(rowp + 32) = pack8(xa * s0 + ya * c0, xb * s1 + yb * c1); }
            }
        } else {
            const int t = pn - 23; PG8_GAS bf16_t* dst = (t < 16 ? GA : GB) + (t & 15) * BM + cw;
#pragma unroll
            for (int ai = 0; ai < 2; ++ai)
#pragma unroll
                for (int m = 0; m < 4; ++m) { const int row = row0 + ai * HALF + m * 16; PG8_GAS bf16_t* rowp = dst + (size_t)row * 4096; const float r = rsl[ai * 64 + m * 16 + fr];
#pragma unroll
                    for (int bj = 0; bj < 2; ++bj) *(PG8_GAS u32x4*)(rowp + bj * HALF) = pack8(sigmoid4(acc[ai][bj][m][0] * r), sigmoid4(acc[ai][bj][m][1] * r)); }
        }
    }
};
struct EpiQ {
    static constexpr bool PERM = true, AFTER_DRAIN = false, ROWSCALE = true; static constexpr float INV_N = 1.f / 1024;
    PG8_GAS bf16_t* Q; const PG8_GAS float* SX; const PG8_GAS float* cs; const PG8_GAS float* sn; int smask;
    __device__ __forceinline__ void operator()(const f32x4 (&acc)[2][2][4][2], const Unit& u, int wr, int wc, int fr, int fq, const PG8_LAS float* rsl) const {
        const int pn = u.pn, row0 = u.pm * BM + wr * 64 + fr;
        if (pn < 8) {
#pragma unroll
            for (int ai = 0; ai < 2; ++ai)
#pragma unroll
                for (int m = 0; m < 4; ++m) { const int row = row0 + ai * HALF + m * 16; const float r = rsl[ai * 64 + m * 16 + fr];
#pragma unroll
                    for (int bj = 0; bj < 2; ++bj) *(PG8_GAS u32x4*)(Q + (size_t)row * 3072 + (2 * pn + bj) * 192 + wc * 32 + 8 * fq) = pack8(acc[ai][bj][m][0] * r, acc[ai][bj][m][1] * r); }
        } else {
            const int head = 4 * (pn - 8) + wc;
#pragma unroll
            for (int ai = 0; ai < 2; ++ai)
#pragma unroll
                for (int m = 0; m < 4; ++m) { const int row = row0 + ai * HALF + m * 16, s = row & smask; const float r = rsl[ai * 64 + m * 16 + fr];
                    const f32x4 c0 = *(const PG8_GAS f32x4*)(cs + (size_t)s * 32 + 8 * fq), c1 = *(const PG8_GAS f32x4*)(cs + (size_t)s * 32 + 8 * fq + 4);
                    const f32x4 s0 = *(const PG8_GAS f32x4*)(sn + (size_t)s * 32 + 8 * fq), s1 = *(const PG8_GAS f32x4*)(sn + (size_t)s * 32 + 8 * fq + 4);
                    const f32x4 xa = acc[ai][0][m][0] * r, xb = acc[ai][0][m][1] * r, ya = acc[ai][1][m][0] * r, yb = acc[ai][1][m][1] * r;
                    PG8_GAS bf16_t* rowp = Q + (size_t)row * 3072 + head * 192 + 128 + 8 * fq;
                    *(PG8_GAS u32x4*)rowp = pack8(xa * c0 - ya * s0, xb * c1 - yb * s1);
                    *(PG8_GAS u32x4*)(rowp + 32) = pack8(xa * s0 + ya * c0, xb * s1 + yb * c1); }
        }
    }
};
struct EpiKV {
    static constexpr bool PERM = true, AFTER_DRAIN = false, ROWSCALE = true; static constexpr float INV_N = 1.f / 512;
    PG8_GAS bf16_t *KN, *V; const PG8_GAS float* SX;
    __device__ __forceinline__ void operator()(const f32x4 (&acc)[2][2][4][2], const Unit& u, int wr, int wc, int fr, int fq, const PG8_LAS float* rsl) const {
        const int row0 = u.pm * BM + wr * 64 + fr, col0 = u.pn * HALF + wc * 32 + 8 * fq;
#pragma unroll
        for (int ai = 0; ai < 2; ++ai)
#pragma unroll
            for (int m = 0; m < 4; ++m) { const int row = row0 + ai * HALF + m * 16; const float r = rsl[ai * 64 + m * 16 + fr];
                *(PG8_GAS u32x4*)(KN + (size_t)row * 2048 + col0) = pack8(acc[ai][0][m][0] * r, acc[ai][0][m][1] * r);
                *(PG8_GAS u32x4*)(V + (size_t)row * 2048 + col0) = pack8(acc[ai][1][m][0] * r, acc[ai][1][m][1] * r); }
    }
};
template <int MODE> struct EpiGate {
    static constexpr bool PERM = true, AFTER_DRAIN = false, ROWSCALE = false;
    PG8_GAS bf16_t* O; const PG8_GAS bf16_t* G; const PG8_GAS bf16_t* P; int ldc;
    __device__ __forceinline__ void operator()(const f32x4 (&acc)[2][2][4][2], const Unit& u, int wr, int wc, int fr, int fq) const {
        const int row0 = u.pm * BM + wr * 64 + fr, col0 = u.pn * BM + wc * 32 + 8 * fq;
#pragma unroll
        for (int ai = 0; ai < 2; ++ai) {
            u32x4 gin[4][2], pin[4][2];
            if (MODE >= 1) {
#pragma unroll
                for (int m = 0; m < 4; ++m)
#pragma unroll
                    for (int bj = 0; bj < 2; ++bj) { const size_t off = (size_t)(row0 + ai * HALF + m * 16) * ldc + col0 + bj * HALF;
                        gin[m][bj] = *(const PG8_GAS u32x4*)(G + off); if (MODE == 2) pin[m][bj] = *(const PG8_GAS u32x4*)(P + off); }
            }
#pragma unroll
            for (int m = 0; m < 4; ++m)
#pragma unroll
                for (int bj = 0; bj < 2; ++bj) { const size_t off = (size_t)(row0 + ai * HALF + m * 16) * ldc + col0 + bj * HALF; f32x4 v0 = acc[ai][bj][m][0], v1 = acc[ai][bj][m][1];
                    if (MODE >= 1) { f32x4 g0, g1; unpack8(gin[m][bj], g0, g1); v0 = v0 * g0; v1 = v1 * g1; }
                    if (MODE == 2) { f32x4 p0, p1; unpack8(pin[m][bj], p0, p1); v0 = v0 + p0; v1 = v1 + p1; }
                    *(PG8_GAS u32x4*)(O + off) = pack8(v0, v1); }
        }
    }
};
template <bool HALF_ALPHA> struct EpiResid {
    static constexpr bool PERM = true, AFTER_DRAIN = false, ROWSCALE = false;
    PG8_GAS bf16_t* X; PG8_GAS float* SX;
    __device__ __forceinline__ void operator()(const f32x4 (&acc)[2][2][4][2], const Unit& u, int wr, int wc, int fr, int fq) const {
        const int row0 = u.pm * BM + wr * 64 + fr, col0 = u.pn * BM + wc * 32 + 8 * fq; const float alpha = HALF_ALPHA ? 0.5f : 1.0f;
        u32x4 xin[2][4][2];
#pragma unroll
        for (int ai = 0; ai < 2; ++ai)
#pragma unroll
            for (int m = 0; m < 4; ++m)
#pragma unroll
                for (int bj = 0; bj < 2; ++bj) xin[ai][m][bj] = *(const PG8_GAS u32x4*)(X + (size_t)(row0 + ai * HALF + m * 16) * 4096 + col0 + bj * HALF);
#pragma unroll
        for (int ai = 0; ai < 2; ++ai)
#pragma unroll
            for (int m = 0; m < 4; ++m) { const int row = row0 + ai * HALF + m * 16; const size_t off = (size_t)row * 4096 + col0; float s = 0.f;
#pragma unroll
                for (int bj = 0; bj < 2; ++bj) { f32x4 x0, x1; unpack8(xin[ai][m][bj], x0, x1);
                    const f32x4 v0 = x0 + acc[ai][bj][m][0] * alpha, v1 = x1 + acc[ai][bj][m][1] * alpha; s += ssq44(v0, v1);
                    *(PG8_GAS u32x4*)(X + off + bj * HALF) = pack8(v0, v1); }
                s = row4_sum(s); if (fq == 0) atomic_add_row(SX + row, s); }
    }
};
struct EpiPleGate {
    static constexpr bool PERM = true, AFTER_DRAIN = false, ROWSCALE = true; static constexpr float INV_N = 1.f / 4096;
    PG8_GAS bf16_t* TT; const PG8_GAS bf16_t* PP; int ldc; PG8_GAS float* sst; const PG8_GAS float* SX;
    __device__ __forceinline__ void operator()(const f32x4 (&acc)[2][2][4][2], const Unit& u, int wr, int wc, int fr, int fq, const PG8_LAS float* rsl) const {
        const int row0 = u.pm * BM + wr * 64 + fr, col0 = u.pn * BM + wc * 32 + 8 * fq;
        u32x4 pin[2][4][2];
#pragma unroll
        for (int ai = 0; ai < 2; ++ai)
#pragma unroll
            for (int m = 0; m < 4; ++m)
#pragma unroll
                for (int bj = 0; bj < 2; ++bj) pin[ai][m][bj] = *(const PG8_GAS u32x4*)(PP + (size_t)(row0 + ai * HALF + m * 16) * ldc + col0 + bj * HALF);
#pragma unroll
        for (int ai = 0; ai < 2; ++ai)
#pragma unroll
            for (int m = 0; m < 4; ++m) { const int row = row0 + ai * HALF + m * 16; const size_t off = (size_t)row * ldc + col0; float s = 0.f; const float r = rsl[ai * 64 + m * 16 + fr];
#pragma unroll
                for (int bj = 0; bj < 2; ++bj) { f32x4 p0, p1; unpack8(pin[ai][m][bj], p0, p1);
                    const f32x4 t0 = sigmoid4(acc[ai][bj][m][0] * r) * p0, t1 = sigmoid4(acc[ai][bj][m][1] * r) * p1;
                    s += ssq44(t0, t1);
                    *(PG8_GAS u32x4*)(TT + off + bj * HALF) = pack8(t0, t1); }
                s = row4_sum(s); if (fq == 0) atomic_add_row(sst + row, s); }
    }
};

template <class Epi, class Sched, bool ALIGN_EPI = false, bool SP2 = false>
__device__ __forceinline__ void gemm_phase(PG8_LAS unsigned char* lds, const Gemm g, const Sched& S, const Epi& E, const int tid) {
    const int wid = __builtin_amdgcn_readfirstlane(tid >> 6), lane = tid & 63, wr = wid >> 2, wc = wid & 3, fr = lane & 15, fq = lane >> 4;
    const int K = g.K, nt = K / BK;
    unsigned voffA[2], voffB[2];
#pragma unroll
    for (int i = 0; i < 2; ++i) { int R, C; stage_rc(tid * 16 + i * 8192, R, C); const int Rb = Epi::PERM ? ((R & ~31) + perm32(R & 31)) : R;
        voffA[i] = (unsigned)(R * K + C) * 2u; voffB[i] = (unsigned)(Rb * K + C) * 2u; }
    const size_t kstep = (size_t)(BK * 2);
    const size_t hstep = (size_t)HALF * K * 2;
    const size_t tstep = 2 * hstep;
    const unsigned ldsw = (unsigned)wid * 1024u;
    const int aoff = lds_byte(wr * 64 + fr, fq * 8), boff = lds_byte(wc * 32 + fr, fq * 8);
#define PG8_SA(b, h) (((b) * 2 + (h)) * HTB)
#define PG8_SB(b, h) ((4 + (b) * 2 + (h)) * HTB)
#define PG8_STAGE(bufoff, gbase, voff) do { _Pragma("unroll") for (int _i = 0; _i < 2; ++_i) \
        __builtin_amdgcn_global_load_lds((const PG8_GAS unsigned*)((const PG8_GAS char*)(gbase) + (voff)[_i]), (PG8_LAS unsigned*)(lds + (bufoff) + ldsw + _i * 8192), 16, 0, 0); } while (0)
#define PG8_LDA(dst, b, h) do { _Pragma("unroll") for (int m = 0; m < 4; ++m) _Pragma("unroll") for (int k = 0; k < 2; ++k) dst[m][k] = *(const PG8_LAS bf16x8*)(lds + PG8_SA(b, h) + aoff + m * 2048 + k * 1024); } while (0)
#define PG8_LDB(dst, b, h) do { _Pragma("unroll") for (int n = 0; n < 2; ++n) _Pragma("unroll") for (int k = 0; k < 2; ++k) dst[n][k] = *(const PG8_LAS bf16x8*)(lds + PG8_SB(b, h) + boff + n * 2048 + k * 1024); } while (0)
#define PG8_MMA(ai, bj, At, Bt) do { __builtin_amdgcn_s_setprio(1); _Pragma("unroll") for (int m = 0; m < 4; ++m) _Pragma("unroll") for (int n = 0; n < 2; ++n) _Pragma("unroll") for (int k = 0; k < 2; ++k) \
        acc[ai][bj][m][n] = __builtin_amdgcn_mfma_f32_16x16x32_bf16(Bt[n][k], At[m][k], acc[ai][bj][m][n], 0, 0, 0); __builtin_amdgcn_s_setprio(0); } while (0)
#define PG8_WAIT_V(n) asm volatile("s_waitcnt vmcnt(" #n ")" ::: "memory")
#define PG8_WAIT_L(n) asm volatile("s_waitcnt lgkmcnt(" #n ")" ::: "memory")
#define PG8_BAR __builtin_amdgcn_s_barrier()
#define PG8_SCHED __builtin_amdgcn_sched_barrier(0)
    Unit cur, nxt; int ui = 0; int rs_tag = -1;
    if (!S.next(0, cur)) return;
    f32x4 acc[2][2][4][2];
#pragma unroll
    for (int a = 0; a < 2; ++a)
#pragma unroll
        for (int b = 0; b < 2; ++b)
#pragma unroll
            for (int m = 0; m < 4; ++m)
#pragma unroll
                for (int n = 0; n < 2; ++n) acc[a][b][m][n] = (f32x4){0.f, 0.f, 0.f, 0.f};
    bf16x8 At[4][2], B0[2][2], B1[2][2];
    const PG8_GAS char* cA = (const PG8_GAS char*)g.A + (size_t)cur.pm * tstep; const PG8_GAS char* cB = (const PG8_GAS char*)g.Bt + (size_t)cur.pn * tstep;
    S.a_ready(cur);
    if constexpr (SP2) {
        PG8_STAGE(PG8_SB(0, 0), cB, voffB); PG8_STAGE(PG8_SB(0, 1), cB + hstep, voffB); PG8_STAGE(PG8_SA(0, 0), cA, voffA); PG8_STAGE(PG8_SA(0, 1), cA + hstep, voffA);
        if (wr == 1) PG8_BAR;
        PG8_WAIT_V(2); PG8_BAR;
        PG8_STAGE(PG8_SB(1, 0), cB + kstep, voffB); PG8_STAGE(PG8_SA(1, 0), cA + kstep, voffA); PG8_STAGE(PG8_SB(1, 1), cB + hstep + kstep, voffB);
        PG8_WAIT_V(6); PG8_BAR;
    } else {
        PG8_STAGE(PG8_SB(0, 0), cB, voffB); PG8_STAGE(PG8_SA(0, 0), cA, voffA); PG8_STAGE(PG8_SB(0, 1), cB + hstep, voffB); PG8_STAGE(PG8_SA(0, 1), cA + hstep, voffA);
        if (wr == 1) PG8_BAR;
        PG8_WAIT_V(4); PG8_BAR;
        PG8_STAGE(PG8_SB(1, 0), cB + kstep, voffB); PG8_STAGE(PG8_SA(1, 0), cA + kstep, voffA); PG8_STAGE(PG8_SB(1, 1), cB + hstep + kstep, voffB);
        PG8_WAIT_V(6); PG8_BAR;
    }
    for (;;) {
        const bool has_next = S.next(ui + 1, nxt);
        const PG8_GAS char* nA = has_next ? (const PG8_GAS char*)g.A + (size_t)nxt.pm * tstep : cA; const PG8_GAS char* nB = has_next ? (const PG8_GAS char*)g.Bt + (size_t)nxt.pn * tstep : cB;
        for (int t = 0; t < nt; t += 2) {
            const bool last = (t == nt - 2);
            const PG8_GAS char* a1 = cA + (size_t)(t + 1) * kstep;
            const PG8_GAS char* a2 = last ? nA : cA + (size_t)(t + 2) * kstep; const PG8_GAS char* b2 = last ? nB : cB + (size_t)(t + 2) * kstep;
            const PG8_GAS char* a3 = a2 + kstep; const PG8_GAS char* b3 = b2 + kstep;
            if (last && has_next) S.a_ready(nxt);
            if constexpr (SP2) {
            PG8_LDB(B0, 0, 0); PG8_LDB(B1, 0, 1); PG8_SCHED; PG8_LDA(At, 0, 0); PG8_STAGE(PG8_SA(1, 1), a1 + hstep, voffA);
            PG8_WAIT_V(8); PG8_WAIT_L(0); PG8_BAR; PG8_MMA(0, 0, At, B0); PG8_MMA(0, 1, At, B1); PG8_BAR; PG8_SCHED;
            PG8_LDA(At, 0, 1); PG8_STAGE(PG8_SB(0, 0), b2, voffB); PG8_STAGE(PG8_SB(0, 1), b2 + hstep, voffB); PG8_STAGE(PG8_SA(0, 0), a2, voffA);
            PG8_WAIT_V(8); PG8_WAIT_L(0); PG8_BAR; PG8_MMA(1, 0, At, B0); PG8_MMA(1, 1, At, B1); PG8_BAR; PG8_SCHED;
            PG8_LDB(B0, 1, 0); PG8_LDB(B1, 1, 1); PG8_SCHED; PG8_LDA(At, 1, 0); PG8_STAGE(PG8_SA(0, 1), a2 + hstep, voffA);
            PG8_WAIT_V(8); PG8_WAIT_L(0); PG8_BAR; PG8_MMA(0, 0, At, B0); PG8_MMA(0, 1, At, B1); PG8_BAR; PG8_SCHED;
            PG8_LDA(At, 1, 1); PG8_STAGE(PG8_SB(1, 0), b3, voffB); PG8_STAGE(PG8_SB(1, 1), b3 + hstep, voffB); PG8_STAGE(PG8_SA(1, 0), a3, voffA);
            PG8_WAIT_V(8); PG8_WAIT_L(0); PG8_BAR; PG8_MMA(1, 0, At, B0); PG8_MMA(1, 1, At, B1); PG8_BAR; PG8_SCHED;
            } else {
            PG8_LDB(B0, 0, 0); PG8_SCHED; PG8_LDA(At, 0, 0); PG8_STAGE(PG8_SA(1, 1), a1 + hstep, voffA);
            PG8_WAIT_L(8); PG8_BAR; PG8_WAIT_L(0); PG8_MMA(0, 0, At, B0); PG8_BAR; PG8_SCHED;
            PG8_LDB(B1, 0, 1); PG8_STAGE(PG8_SB(0, 0), b2, voffB);
            PG8_BAR; PG8_WAIT_L(0); PG8_MMA(0, 1, At, B1); PG8_BAR;
            PG8_LDA(At, 0, 1); PG8_STAGE(PG8_SA(0, 0), a2, voffA);
            PG8_BAR; PG8_WAIT_L(0); PG8_MMA(1, 0, At, B0); PG8_BAR; PG8_SCHED;
            PG8_STAGE(PG8_SB(0, 1), b2 + hstep, voffB);
            PG8_WAIT_V(6); PG8_BAR; PG8_MMA(1, 1, At, B1); PG8_BAR;
            PG8_LDB(B0, 1, 0); PG8_SCHED; PG8_LDA(At, 1, 0); PG8_STAGE(PG8_SA(0, 1), a2 + hstep, voffA);
            PG8_WAIT_L(8); PG8_BAR; PG8_WAIT_L(0); PG8_MMA(0, 0, At, B0); PG8_BAR; PG8_SCHED;
            PG8_LDB(B1, 1, 1); PG8_STAGE(PG8_SB(1, 0), b3, voffB);
            PG8_BAR; PG8_WAIT_L(0); PG8_MMA(0, 1, At, B1); PG8_BAR;
            PG8_LDA(At, 1, 1); PG8_STAGE(PG8_SA(1, 0), a3, voffA);
            PG8_BAR; PG8_WAIT_L(0); PG8_MMA(1, 0, At, B0); PG8_BAR; PG8_SCHED;
            PG8_STAGE(PG8_SB(1, 1), b3 + hstep, voffB);
            PG8_WAIT_V(6); PG8_BAR; PG8_MMA(1, 1, At, B1); PG8_BAR;
            }
        }
        if constexpr (ALIGN_EPI) { if (wr == 0) PG8_BAR; }
        if constexpr (!Epi::AFTER_DRAIN) {
            if constexpr (Epi::ROWSCALE) {
                PG8_LAS float* rsl = (PG8_LAS float*)(lds + RS_OFF + wid * 512);
                if (cur.pm != rs_tag) { rs_tag = cur.pm; const int rb = cur.pm * BM + wr * 64 + lane; rsl[lane] = rstd_from_ss(E.SX[rb], Epi::INV_N); rsl[64 + lane] = rstd_from_ss(E.SX[rb + HALF], Epi::INV_N); }
                E(acc, cur, wr, wc, fr, fq, rsl);
            } else E(acc, cur, wr, wc, fr, fq);
            S.done(cur); }
        if (!has_next) break;
#pragma unroll
        for (int a = 0; a < 2; ++a)
#pragma unroll
            for (int b = 0; b < 2; ++b)
#pragma unroll
                for (int m = 0; m < 4; ++m)
#pragma unroll
                    for (int n = 0; n < 2; ++n) acc[a][b][m][n] = (f32x4){0.f, 0.f, 0.f, 0.f};
        cur = nxt; cA = nA; cB = nB; ++ui;
        if constexpr (ALIGN_EPI) { if (wr == 1) PG8_BAR; }
    }
    PG8_WAIT_V(0);
    if constexpr (!ALIGN_EPI) { if (wr == 0) PG8_BAR; }
    PG8_BAR;
#undef PG8_SA
#undef PG8_SB
#undef PG8_STAGE
#undef PG8_LDA
#undef PG8_LDB
#undef PG8_MMA
#undef PG8_WAIT_V
#undef PG8_WAIT_L
#undef PG8_BAR
#undef PG8_SCHED
}
}

constexpr int NWAVES = 8;
constexpr int D = 4096, DFF = 11008, MROWS = 16384, NGRP = 2, PLE = 256, GMW = 2048, NH = 16, QLR = 1024, KVR = 512;
constexpr int INW = 13888, INWP = 14080, QW = 3072, KVW = 4096;
constexpr float EPS = 1e-6f;
constexpr size_t MiB = 1u << 20;
constexpr size_t WS_CTL = 0, CTL_ZERO_BYTES = 1152 * 1024;
constexpr size_t WS_COS = 2 * MiB, WS_SIN = 3 * MiB, WS_SS = 256 * 1024;
constexpr size_t WS_WF1U = 8 * MiB, WS_WF1D = WS_WF1U + 172 * MiB, WS_WF2U = WS_WF1D + 86 * MiB, WS_WF2D = WS_WF2U + 172 * MiB;
constexpr size_t WS_WIN = WS_WF2D + 86 * MiB, WS_WOA = WS_WIN + 110 * MiB, WS_WOB = WS_WOA + 16 * MiB, WS_WUQ = WS_WOB + 16 * MiB, WS_WUKV = WS_WUQ + 6 * MiB;
constexpr size_t WS_WO = WS_WUKV + 4 * MiB, WS_WPG = WS_WO + 32 * MiB, WS_WPP = WS_WPG + 32 * MiB, WS_WEND = WS_WPP + 2 * MiB;
static_assert(WS_WEND == 742 * MiB, "weight map");
constexpr size_t WS_XN = 744 * MiB;
constexpr size_t WS_R1 = WS_XN + 256 * MiB;
constexpr size_t WS_H = WS_R1, WS_GU = WS_R1, WS_GV = WS_R1 + 64 * MiB, WS_QL = WS_R1 + 128 * MiB, WS_KVL = WS_R1 + 160 * MiB, WS_KR = WS_R1 + 176 * MiB;
constexpr size_t WS_GA = WS_R1 + 192 * MiB, WS_GB = WS_R1 + 320 * MiB, WS_PP = WS_R1, WS_TT = WS_R1 + 256 * MiB;
constexpr size_t WS_Q = WS_R1 + 448 * MiB, WS_KN = WS_Q + 96 * MiB, WS_M1 = WS_GU, WS_MG = WS_KN, WS_V = WS_KN + 64 * MiB, WS_AO = WS_V + 64 * MiB, WS_GM = WS_AO + 64 * MiB;
constexpr size_t WS_PB = WS_R1 + 800 * MiB;
constexpr size_t WS_END = WS_PB + 16 * MiB;
static_assert((size_t)2 * MROWS * DFF * 2 <= 800 * MiB && WS_GM + 64 * MiB == WS_R1 + 800 * MiB && WS_END == 1816 * MiB, "activation map");
constexpr int CW_BAR = 4096, CW_XRANK = 12288;
constexpr size_t WS_SX = 640 * 1024;
constexpr size_t WS_SST = 65536;
constexpr int RING_OFF = 0, RING_BYTES = 131072;
constexpr int LDSCTL_OFF = RING_BYTES, MISC_OFF = LDSCTL_OFF + 320;
constexpr int LDS_BYTES = 147456;

#define GAS __attribute__((address_space(1)))
#define LAS __attribute__((address_space(3)))
typedef unsigned short bf16;
typedef unsigned v4u __attribute__((ext_vector_type(4)));
typedef unsigned v2u __attribute__((ext_vector_type(2)));
typedef float f32x4 __attribute__((ext_vector_type(4)));
typedef float f32x16 __attribute__((ext_vector_type(16)));
typedef short bf16x8 __attribute__((ext_vector_type(8)));
typedef short s16x4 __attribute__((ext_vector_type(4)));
typedef GAS unsigned gu32;
#define RLX_AGENT __ATOMIC_RELAXED, __HIP_MEMORY_SCOPE_AGENT
#define LDS_WAIT() asm volatile("s_waitcnt lgkmcnt(0)" ::: "memory")
#define VM_WAIT() asm volatile("s_waitcnt vmcnt(0)" ::: "memory")
__device__ __forceinline__ unsigned f2bf(float f) { unsigned u = __builtin_bit_cast(unsigned, f); return (u + 0x7fffu + ((u >> 16) & 1u)) >> 16; }
__device__ __forceinline__ unsigned pk2(float lo, float hi) { return f2bf(lo) | (f2bf(hi) << 16); }

#define XB_TMO      128
#define XB_XCNT(j)  (256  + 64 * (j))
#define XB_XSUB(j)  (1280 + 64 * (j))
#define XB_XGEN(j)  (2304 + 64 * (j))
#define XB_TOP      3328
#define XB_TOPGEN   3392
#define XCD_BAR_WORDS 3456
#define XB_SPIN_CAP (1u << 20)
__device__ __forceinline__ unsigned xb_ld(unsigned* p)              { return __hip_atomic_load(p, __ATOMIC_RELAXED, __HIP_MEMORY_SCOPE_AGENT); }
__device__ __forceinline__ unsigned xb_add(unsigned* p, unsigned v) { return __hip_atomic_fetch_add(p, v, __ATOMIC_RELAXED, __HIP_MEMORY_SCOPE_AGENT); }
__device__ __forceinline__ unsigned xb_xcc_id() { return (unsigned)__builtin_amdgcn_s_getreg((3 << 11) | 20) & 0xFu; }
#define XB_SPIN(cond, bar) do { unsigned _sp = 0; while (cond) { __builtin_amdgcn_s_sleep(1); \
    if ((++_sp & 255u) == 0u) { if (xb_ld(&(bar)[XB_TMO])) break; if (_sp > XB_SPIN_CAP) { atomicAdd(&(bar)[XB_TMO], 1u); break; } } } } while (0)
struct XcdBarrier { unsigned* bar; unsigned x; volatile LAS unsigned* st; bool leader; };
__device__ __forceinline__ XcdBarrier xcd_barrier_post(unsigned* bar, volatile LAS unsigned* st, bool leader) {
    XcdBarrier b; b.bar = bar; b.x = xb_xcc_id(); b.st = st; b.leader = leader;
    if (leader) (void)xb_add(&bar[XB_XCNT(b.x)], 1u);
    return b;
}
__device__ __forceinline__ void xcd_barrier_complete(unsigned* bar, unsigned x, unsigned& nloc, unsigned& nx) {
    const unsigned G = gridDim.x * gridDim.y * gridDim.z;
    unsigned sum, cnt, mine, sp = 0u;
    for (;;) {
        sum = 0u; cnt = 0u; mine = 0u;
#pragma unroll
        for (unsigned j = 0; j < 16; ++j) { const unsigned c = xb_ld(&bar[XB_XCNT(j)]); sum += c; cnt += (c > 0u) ? 1u : 0u; mine = (j == x) ? c : mine; }
        if (sum == G) break;
        __builtin_amdgcn_s_sleep(1);
        if ((++sp & 255u) == 0u) { if (xb_ld(&bar[XB_TMO])) break; if (sp > XB_SPIN_CAP) { atomicAdd(&bar[XB_TMO], 1u); break; } }
    }
    nloc = mine > 0u ? mine : 1u; nx = cnt > 0u ? cnt : 1u;
}
__device__ __forceinline__ void xcd_barrier(const XcdBarrier& b) {
    asm volatile("s_waitcnt vmcnt(0)" ::: "memory");
    __syncthreads();
    if (b.leader) {
        unsigned* bar = b.bar;
        __builtin_amdgcn_s_waitcnt(0);
        unsigned nloc = b.st[0], nx = b.st[1];
        if (nloc == 0u) { xcd_barrier_complete(bar, b.x, nloc, nx); b.st[0] = nloc; b.st[1] = nx; }
        const unsigned old = xb_add(&bar[XB_XSUB(b.x)], 1u);
        const unsigned gen = old / nloc;
        if (old + 1u == (gen + 1u) * nloc) {
            __builtin_amdgcn_fence(__ATOMIC_RELEASE, "agent");
            asm volatile("s_waitcnt vmcnt(0)" ::: "memory");
            const unsigned og = xb_add(&bar[XB_TOP], 1u);
            const unsigned tg = og / nx;
            if (og + 1u == (tg + 1u) * nx) xb_add(&bar[XB_TOPGEN], 1u);
            else XB_SPIN(xb_ld(&bar[XB_TOPGEN]) == tg, bar);
            __builtin_amdgcn_fence(__ATOMIC_ACQUIRE, "agent");
            xb_add(&bar[XB_XGEN(b.x)], 1u);
            asm volatile("s_waitcnt vmcnt(0)" ::: "memory");
        } else {
            XB_SPIN(xb_ld(&bar[XB_XGEN(b.x)]) == gen, bar);
            __builtin_amdgcn_fence(__ATOMIC_ACQUIRE, "agent");
            asm volatile("s_waitcnt vmcnt(0)" ::: "memory");
        }
    }
    __syncthreads();
}

struct Args { const float* in[29]; float* out; unsigned char* ws; };
typedef GAS float gf32; typedef GAS unsigned short gbf16;
struct Frame {
    LAS unsigned char* lds;
    int tid, lane, wave, G, bid, gw, ngw;
    int xc, wx;
};
__device__ __forceinline__ float wave_sum(float v) {
    v += __int_as_float(__builtin_amdgcn_ds_swizzle(__float_as_int(v), (1 << 10) | 0x1f));
    v += __int_as_float(__builtin_amdgcn_ds_swizzle(__float_as_int(v), (2 << 10) | 0x1f));
    v += __int_as_float(__builtin_amdgcn_ds_swizzle(__float_as_int(v), (4 << 10) | 0x1f));
    v += __int_as_float(__builtin_amdgcn_ds_swizzle(__float_as_int(v), (8 << 10) | 0x1f));
    v += __int_as_float(__builtin_amdgcn_ds_swizzle(__float_as_int(v), (16 << 10) | 0x1f));
    auto rr = __builtin_amdgcn_permlane32_swap(__float_as_uint(v), __float_as_uint(v), false, false);
    return __uint_as_float(rr[0]) + __uint_as_float(rr[1]);
}

__device__ __forceinline__ void tr_item(const gf32* W, int ldw, int k0, int n0src, gbf16* WT, int K, int row0dst, const gf32* kscale, LAS float* scr, int lane) {
    f32x4 wv[8];
#pragma unroll
    for (int i = 0; i < 8; ++i) wv[i] = *(const GAS f32x4*)(W + (size_t)(k0 + 8 * i + (lane >> 3)) * ldw + n0src + (lane & 7) * 4);
#pragma unroll
    for (int i = 0; i < 8; ++i) { LAS float* d = scr + (8 * i + (lane >> 3)) * 33 + (lane & 7) * 4; d[0] = wv[i].x; d[1] = wv[i].y; d[2] = wv[i].z; d[3] = wv[i].w; }
    LDS_WAIT(); asm volatile("" ::: "memory");
    const int c = lane & 7;
    f32x4 ka = (f32x4){1.f, 1.f, 1.f, 1.f}, kb = ka;
    if (kscale) { ka = *(const GAS f32x4*)(kscale + k0 + 8 * c); kb = *(const GAS f32x4*)(kscale + k0 + 8 * c + 4); }
#pragma unroll
    for (int j = 0; j < 4; ++j) { const int n = (lane >> 3) + 8 * j; const LAS float* s = scr + (8 * c) * 33 + n;
        v4u o; o.x = pk2(s[0 * 33] * ka.x, s[1 * 33] * ka.y); o.y = pk2(s[2 * 33] * ka.z, s[3 * 33] * ka.w); o.z = pk2(s[4 * 33] * kb.x, s[5 * 33] * kb.y); o.w = pk2(s[6 * 33] * kb.z, s[7 * 33] * kb.w);
        *(GAS v4u*)(WT + (size_t)(row0dst + n) * K + k0 + 8 * c) = o; }
    LDS_WAIT(); asm volatile("" ::: "memory");
}
template <int MAP> __device__ __forceinline__ void tr_matrix(const Frame& F, const gf32* W, const gf32* W2, int ldw, int K, int NP, gbf16* WT, const gf32* kscale, LAS float* scr, int& base) {
    const int nkb = K / 64, nnb = NP / 32, nitems = nkb * nnb;
    int it = ((F.gw - base) % F.ngw + F.ngw) % F.ngw;
    for (; it < nitems; it += F.ngw) {
        const int nb = it / nkb, kb = it % nkb, n0 = nb * 32; const gf32* src = W; int c0 = n0;
        if (MAP == 1) { const int t = n0 >> 8, r = n0 & 255; src = (r >= 128) ? W2 : W; c0 = 128 * t + (r & 127); }
        if (MAP == 2) { const int t = n0 >> 8, r = n0 & 255; if (t < 22) c0 = n0; else if (t == 22) c0 = (r == 128) ? 5664 : 5632; else c0 = 5696 + (n0 - 23 * 256); }
        if (MAP == 3) { if (n0 < 2048) { const int t = n0 >> 8, bj = (n0 >> 7) & 1, jj = n0 & 127; c0 = (2 * t + bj) * 192 + jj; }
                        else { const int r = n0 - 2048, t = r >> 8, bj = (r >> 7) & 1, hh = (r >> 5) & 3; c0 = (4 * t + hh) * 192 + 128 + 32 * bj; } }
        tr_item(src, ldw, kb * 64, c0, WT, K, n0, kscale, scr, F.lane);
    }
    base = (base + nitems) % F.ngw;
}

__device__ __forceinline__ void row_to_bf16_ss(const gf32* xrow, gbf16* orow, gf32* ss, int lane) {
    const GAS f32x4* xr = (const GAS f32x4*)xrow + lane; GAS v2u* o8 = (GAS v2u*)orow + lane; float s = 0.f;
#pragma unroll
    for (int j = 0; j < 16; ++j) { const f32x4 v = xr[64 * j]; s += (v.x * v.x + v.y * v.y) + (v.z * v.z + v.w * v.w); v2u w; w.x = pk2(v.x, v.y); w.y = pk2(v.z, v.w); o8[64 * j] = w; }
    s = wave_sum(s); if (lane == 0) *ss = s;
}
__device__ __forceinline__ float ssq8(const v4u w) {
    const float a = pg8::bf_lo(w.x), b = pg8::bf_hi(w.x), c = pg8::bf_lo(w.y), d = pg8::bf_hi(w.y), e = pg8::bf_lo(w.z), f = pg8::bf_hi(w.z), g = pg8::bf_lo(w.w), h = pg8::bf_hi(w.w);
    return ((a * a + b * b) + (c * c + d * d)) + ((e * e + f * f) + (g * g + h * h));
}

__device__ __forceinline__ void gmlp_phase(const Frame& F, const gf32* ws, const gf32* bs, const gf32* gvn, const gbf16* GU, const gbf16* GV, const gf32* RSV, gbf16* GM) {
    LAS unsigned char* As = F.lds;
    LAS unsigned char* Bs = F.lds + 34816;
    LAS float* rsl = (LAS float*)(F.lds + 69632);
    const int tid = F.tid, lane = F.lane, w = F.wave, fr = lane & 15, fq = lane >> 4;
    const int nitems = (MROWS / 128) * 16;
    (void)nitems;
    for (int k_ = 0; k_ < 8; ++k_) { const int ii = (F.bid >> 3) + 32 * k_;
        const int ch = 16 * F.xc + (ii >> 4), gg = ii & 15, row0 = ch * 128;
        if (tid < 128) rsl[tid] = pg8::rstd_from_ss(RSV[row0 + tid], 1.f / GMW);
        __syncthreads();
#pragma unroll
        for (int i = 0; i < 4; ++i) { const int c = tid + 512 * i, p = c >> 4, q8 = c & 15;
            const f32x4 w0 = *(const GAS f32x4*)(ws + ((size_t)(gg * 128 + p)) * 128 + q8 * 8), w1 = *(const GAS f32x4*)(ws + ((size_t)(gg * 128 + p)) * 128 + q8 * 8 + 4);
            const f32x4 r0 = *(const LAS f32x4*)(rsl + q8 * 8), r1 = *(const LAS f32x4*)(rsl + q8 * 8 + 4);
            *(LAS v4u*)(As + p * 272 + q8 * 16) = pg8::pack8(w0 * r0, w1 * r1); }
#pragma unroll
        for (int i = 0; i < 4; ++i) { const int c = tid + 512 * i, q = c >> 4, c8 = c & 15;
            const v4u v = *(const GAS v4u*)(GV + (size_t)(row0 + q) * GMW + gg * 128 + c8 * 8);
            const int qq = (q ^ (c8 << 3)) * 2; LAS unsigned char* bp = Bs + (c8 * 8) * 272 + qq;
            *(LAS unsigned short*)(bp + 0 * 272) = (unsigned short)(v.x & 0xffffu); *(LAS unsigned short*)(bp + 1 * 272) = (unsigned short)(v.x >> 16);
            *(LAS unsigned short*)(bp + 2 * 272) = (unsigned short)(v.y & 0xffffu); *(LAS unsigned short*)(bp + 3 * 272) = (unsigned short)(v.y >> 16);
            *(LAS unsigned short*)(bp + 4 * 272) = (unsigned short)(v.z & 0xffffu); *(LAS unsigned short*)(bp + 5 * 272) = (unsigned short)(v.z >> 16);
            *(LAS unsigned short*)(bp + 6 * 272) = (unsigned short)(v.w & 0xffffu); *(LAS unsigned short*)(bp + 7 * 272) = (unsigned short)(v.w >> 16); }
        __syncthreads();
        f32x4 acc[8];
#pragma unroll
        for (int ni = 0; ni < 8; ++ni) acc[ni] = (f32x4){0.f, 0.f, 0.f, 0.f};
#pragma unroll
        for (int kb = 0; kb < 4; ++kb) {
            const bf16x8 a = *(const LAS bf16x8*)(As + (16 * w + fr) * 272 + (kb * 32 + fq * 8) * 2);
#pragma unroll
            for (int ni = 0; ni < 8; ++ni) { const int cc = 16 * ni + fr, c8 = cc >> 3;
                const bf16x8 b = *(const LAS bf16x8*)(Bs + cc * 272 + (((kb * 32 + fq * 8) ^ (c8 << 3)) * 2));
                acc[ni] = __builtin_amdgcn_mfma_f32_16x16x32_bf16(b, a, acc[ni], 0, 0, 0); }
        }
        const int row = row0 + 16 * w + fr; const float bsv = bs[gg * 128 + 16 * w + fr];
#pragma unroll
        for (int ni = 0; ni < 8; ++ni) { const int c0 = gg * 128 + 16 * ni + 4 * fq;
            const v2u gu = *(const GAS v2u*)(GU + (size_t)row * GMW + c0); const f32x4 gn = *(const GAS f32x4*)(gvn + c0);
            const float o0 = pg8::bf_lo(gu.x) * (gn[0] * acc[ni][0] + bsv), o1 = pg8::bf_hi(gu.x) * (gn[1] * acc[ni][1] + bsv);
            const float o2 = pg8::bf_lo(gu.y) * (gn[2] * acc[ni][2] + bsv), o3 = pg8::bf_hi(gu.y) * (gn[3] * acc[ni][3] + bsv);
            v2u o; o.x = pg8::cvt_pk_bf16(o0, o1); o.y = pg8::cvt_pk_bf16(o2, o3);
            *(GAS v2u*)(GM + (size_t)row * GMW + c0) = o; }
        __syncthreads();
    }
}

namespace att {
constexpr float SCALE = 0.07216878364870322f;
constexpr float THR = 8.f;
constexpr int SHM_V = 16384, SHM_K = 24576;
constexpr int OFF_V = 0, OFF_K = 2 * SHM_V, OFF_S = OFF_K + 2 * SHM_K;
#define KSWZ(row, colB) ((row) * 384 + ((colB) ^ ((((row) >> 1) & 7) << 4)))
#define SBAR() __builtin_amdgcn_sched_barrier(0)
__device__ __forceinline__ int crow(int r, int hi) { return (r & 3) + 8 * (r >> 2) + 4 * hi; }
__device__ __forceinline__ unsigned cvtpk(float lo, float hi) { unsigned r; asm volatile("s_nop 1\n\tv_cvt_pk_bf16_f32 %0, %1, %2" : "=v"(r) : "v"(lo), "v"(hi)); return r; }
__device__ __forceinline__ void partialSM(f32x16& p0, f32x16& p1, float& m_reg, float& mn, float& alpha) {
    constexpr float C = SCALE * 1.4426950408889634f;
    float pmax = p0[0];
#pragma unroll
    for (int r = 1; r < 16; ++r) pmax = fmaxf(pmax, p0[r]);
#pragma unroll
    for (int r = 0; r < 16; ++r) pmax = fmaxf(pmax, p1[r]);
    { auto rr = __builtin_amdgcn_permlane32_swap(__float_as_uint(pmax), __float_as_uint(pmax), false, false);
      pmax = fmaxf(__uint_as_float(rr[0]), __uint_as_float(rr[1])); }
    if (__builtin_expect(__all(pmax - m_reg <= THR / SCALE), 1)) { mn = m_reg; alpha = 1.f; }
    else { mn = fmaxf(m_reg, pmax); alpha = __builtin_amdgcn_exp2f((m_reg - mn) * C); m_reg = mn; }
    const float mnC = -mn * C;
#pragma unroll
    for (int r = 0; r < 16; ++r) p0[r] = fmaf(p0[r], C, mnC);
#pragma unroll
    for (int r = 0; r < 16; ++r) p1[r] = fmaf(p1[r], C, mnC);
#pragma unroll
    for (int r = 0; r < 16; ++r) p0[r] = __builtin_amdgcn_exp2f(p0[r]);
}
__device__ __forceinline__ void finishSM(f32x16& p0, f32x16& p1, float alpha, float& l_reg, bf16x8& pa0, bf16x8& pa1, bf16x8& pa2, bf16x8& pa3) {
#pragma unroll
    for (int r = 0; r < 16; ++r) p1[r] = __builtin_amdgcn_exp2f(p1[r]);
    float ps = 0;
#pragma unroll
    for (int r = 0; r < 16; ++r) ps += p0[r];
#pragma unroll
    for (int r = 0; r < 16; ++r) ps += p1[r];
    { auto rr = __builtin_amdgcn_permlane32_swap(__float_as_uint(ps), __float_as_uint(ps), false, false);
      ps = __uint_as_float(rr[0]) + __uint_as_float(rr[1]); }
    l_reg = l_reg * alpha + ps;
#define PK4(P, BASE, OUT) do { unsigned a0 = cvtpk(P[BASE + 0], P[BASE + 1]), a1 = cvtpk(P[BASE + 2], P[BASE + 3]);   \
    unsigned b0 = cvtpk(P[BASE + 4], P[BASE + 5]), b1 = cvtpk(P[BASE + 6], P[BASE + 7]);                              \
    auto r0 = __builtin_amdgcn_permlane32_swap(a0, b0, false, false); auto r1 = __builtin_amdgcn_permlane32_swap(a1, b1, false, false); \
    v4u w = {r0[0], r1[0], r0[1], r1[1]}; OUT = __builtin_bit_cast(bf16x8, w); } while (0)
    PK4(p0, 0, pa0); PK4(p0, 8, pa1); PK4(p1, 0, pa2); PK4(p1, 8, pa3);
#undef PK4
}
__device__ __forceinline__ void qkt(f32x16& p0, f32x16& p1, const LAS unsigned char* Ks, const bf16x8 (&qr)[12], int r32, int hi) {
    p0 = f32x16{}; p1 = f32x16{};
    bf16x8 b0 = *(const LAS bf16x8*)(Ks + KSWZ(r32, (hi * 8) * 2)), b1 = *(const LAS bf16x8*)(Ks + KSWZ(32 + r32, (hi * 8) * 2));
#pragma unroll
    for (int d0 = 0; d0 < 12; ++d0) { const int cn = ((d0 + 1) * 16 + hi * 8) * 2; bf16x8 n0 = b0, n1 = b1;
        if (d0 < 11) { n0 = *(const LAS bf16x8*)(Ks + KSWZ(r32, cn)); n1 = *(const LAS bf16x8*)(Ks + KSWZ(32 + r32, cn)); }
        SBAR();
        p0 = __builtin_amdgcn_mfma_f32_32x32x16_bf16(b0, qr[d0], p0, 0, 0, 0);
        p1 = __builtin_amdgcn_mfma_f32_32x32x16_bf16(b1, qr[d0], p1, 0, 0, 0);
        SBAR();
        b0 = n0; b1 = n1; }
}
__device__ __forceinline__ int v_st(int k, int c) { const int kk = (k & ~0xC) | ((k & 4) << 1) | ((k & 8) >> 1); return ((kk >> 3) * 4 + (c >> 5)) * 512 + ((kk & 7) * 32 + (c & 31)) * 2; }
__device__ __forceinline__ int v_rd_base(int lane) { return ((lane & 3) << 3) | (((lane >> 2) & 3) << 6) | (((lane >> 4) & 1) << 5) | (((lane >> 5) & 1) << 8); }
constexpr int v_rd_off(int d0, int ks, int half) { return d0 * 512 + ks * 4096 + half * 2048; }
template <int OFF> __device__ __forceinline__ s16x4 tr_read(int vb) {
    s16x4 r; asm volatile("ds_read_b64_tr_b16 %0, %1 offset:%2" : "=&v"(r) : "v"(vb), "i"(OFF) : "memory"); return r;
}
__device__ __forceinline__ void pv_all(f32x16 (&o)[4], int vb, bf16x8 pa0, bf16x8 pa1, bf16x8 pa2, bf16x8 pa3) {
#define PK(L, H) (bf16x8){L[0], L[1], L[2], L[3], H[0], H[1], H[2], H[3]}
#define TRSET(S, D0) do { S##l0 = tr_read<v_rd_off(D0, 0, 0)>(vb); S##h0 = tr_read<v_rd_off(D0, 0, 1)>(vb); S##l1 = tr_read<v_rd_off(D0, 1, 0)>(vb); S##h1 = tr_read<v_rd_off(D0, 1, 1)>(vb); \
                          S##l2 = tr_read<v_rd_off(D0, 2, 0)>(vb); S##h2 = tr_read<v_rd_off(D0, 2, 1)>(vb); S##l3 = tr_read<v_rd_off(D0, 3, 0)>(vb); S##h3 = tr_read<v_rd_off(D0, 3, 1)>(vb); } while (0)
#define PVMMA(S, od) do { od = __builtin_amdgcn_mfma_f32_32x32x16_bf16(pa0, PK(S##l0, S##h0), od, 0, 0, 0); od = __builtin_amdgcn_mfma_f32_32x32x16_bf16(pa1, PK(S##l1, S##h1), od, 0, 0, 0); \
                          od = __builtin_amdgcn_mfma_f32_32x32x16_bf16(pa2, PK(S##l2, S##h2), od, 0, 0, 0); od = __builtin_amdgcn_mfma_f32_32x32x16_bf16(pa3, PK(S##l3, S##h3), od, 0, 0, 0); } while (0)
#define LWAIT(n) do { asm volatile("s_waitcnt lgkmcnt(" #n ")" ::: "memory"); SBAR(); } while (0)
    s16x4 Al0, Ah0, Al1, Ah1, Al2, Ah2, Al3, Ah3, Bl0, Bh0, Bl1, Bh1, Bl2, Bh2, Bl3, Bh3;
    TRSET(A, 0); TRSET(B, 1); LWAIT(8); PVMMA(A, o[0]); SBAR();
    TRSET(A, 2); LWAIT(8); PVMMA(B, o[1]); SBAR();
    TRSET(B, 3); LWAIT(8); PVMMA(A, o[2]); SBAR();
    LWAIT(0); PVMMA(B, o[3]);
#undef PK
#undef TRSET
#undef PVMMA
#undef LWAIT
}
__device__ __forceinline__ void attn_unit(const gbf16* Qb, const gbf16* Kh, const gbf16* Rh, const gbf16* Vh, gbf16* Ob, int seq, LAS unsigned char* lds, int tid) {
    constexpr int LDQ = 3072, LDK = 2048, LDR = 64, LDO = 2048;
    const int wid = tid >> 6, lane = tid & 63, r32 = lane & 31, hi = lane >> 5;
    LAS unsigned char* V_lds = lds + OFF_V; LAS unsigned char* K_lds = lds + OFF_K;
    LAS float* wsf = (LAS float*)(lds + OFF_S) + wid * 64; LAS float* li_l = wsf; LAS float* al_l = wsf + 32;
    float m_reg = -1e30f, l_reg = 0.f; f32x16 o[4] = {}; bf16x8 qr[12];
    const GAS bf16* Qw = Qb + (size_t)(wid * 32 + r32) * LDQ + hi * 8;
#pragma unroll
    for (int d0 = 0; d0 < 12; ++d0) qr[d0] = *(const GAS bf16x8*)(Qw + d0 * 16);
    const int sr = tid >> 4, sc = (tid & 15) * 8, vst0 = v_st(sr, sc), vst1 = v_st(32 + sr, sc);
    const int rr = tid >> 3, rc = (tid & 7) * 8;
    const int vb0 = (int)(unsigned)(uintptr_t)V_lds + v_rd_base(lane);
    bf16x8 vs0, vs1, ks0, ks1, ks2;
    const unsigned vo_kv = (unsigned)(sr * LDK + sc) * 2u, vo_r = (unsigned)(rr * LDR + rc) * 2u;
#define SLOADK(k0) do { const GAS char* kb_ = (const GAS char*)Kh + (size_t)(k0) * (LDK * 2); const GAS char* rb_ = (const GAS char*)Rh + (size_t)(k0) * (LDR * 2); \
    unsigned o1_ = vo_kv, o2_ = vo_r; asm volatile("" : "+v"(o1_), "+v"(o2_));     \
    ks0 = *(const GAS bf16x8*)(kb_ + o1_); ks1 = *(const GAS bf16x8*)(kb_ + 32 * LDK * 2 + o1_); ks2 = *(const GAS bf16x8*)(rb_ + o2_); } while (0)
#define SLOADV(k0) do { const GAS char* vb_ = (const GAS char*)Vh + (size_t)(k0) * (LDK * 2); unsigned o1_ = vo_kv; asm volatile("" : "+v"(o1_)); \
    vs0 = *(const GAS bf16x8*)(vb_ + o1_); vs1 = *(const GAS bf16x8*)(vb_ + 32 * LDK * 2 + o1_); } while (0)
#define SWRITEK(b) do { *(LAS bf16x8*)(K_lds + (b) * SHM_K + KSWZ(sr, sc * 2)) = ks0; *(LAS bf16x8*)(K_lds + (b) * SHM_K + KSWZ(32 + sr, sc * 2)) = ks1; \
    *(LAS bf16x8*)(K_lds + (b) * SHM_K + KSWZ(rr, 256 + rc * 2)) = ks2; } while (0)
#define SWRITEV(b) do { *(LAS bf16x8*)(V_lds + (b) * SHM_V + vst0) = vs0; *(LAS bf16x8*)(V_lds + (b) * SHM_V + vst1) = vs1; } while (0)
    const int NT = seq / 64, grp = __builtin_amdgcn_readfirstlane(wid >> 2);
    SLOADK(0); SWRITEK(0);
    SLOADK(64); SLOADV(0);
    f32x16 p0, p1; float mn, al; bf16x8 pa0, pa1, pa2, pa3;
#define ST_BAR() do { LDS_WAIT(); __builtin_amdgcn_s_barrier(); asm volatile("" ::: "memory"); } while (0)
#define ST_WRITES(j) do { if ((j) + 1 < NT) SWRITEK(((j) + 1) & 1); SWRITEV((j) & 1); if ((j) + 2 < NT) SLOADK(((j) + 2) * 64); if ((j) + 1 < NT) SLOADV(((j) + 1) * 64); } while (0)
#define ST_PV(j) do { const int vb = vb0 + ((j) & 1) * SHM_V; SBAR(); \
        pv_all(o, vb, pa0, pa1, pa2, pa3); } while (0)
#define ST_QK(j) do { SBAR(); qkt(p0, p1, K_lds + ((j) & 1) * SHM_K, qr, r32, hi); } while (0)
#define ST_SM() do { partialSM(p0, p1, m_reg, mn, al); \
        if (__any(al < 1.f)) { if (hi == 0) al_l[r32] = al; LDS_WAIT(); \
            _Pragma("unroll") for (int d = 0; d < 4; ++d) _Pragma("unroll") for (int r = 0; r < 16; ++r) o[d][r] *= al_l[crow(r, hi)]; } \
        finishSM(p0, p1, al, l_reg, pa0, pa1, pa2, pa3); SBAR(); } while (0)
    if (grp == 0) {
        ST_BAR(); ST_QK(0); ST_BAR(); ST_WRITES(0); ST_SM();
        for (int j = 1; j < NT; ++j) { ST_BAR(); ST_PV(j - 1); ST_QK(j); ST_BAR(); ST_WRITES(j); ST_SM(); }
        ST_BAR(); ST_PV(NT - 1); ST_BAR();
    } else {
        ST_BAR(); ST_BAR(); ST_WRITES(0); ST_QK(0); ST_BAR(); ST_SM();
        for (int j = 1; j < NT; ++j) { ST_BAR(); ST_WRITES(j); ST_PV(j - 1); ST_QK(j); ST_BAR(); ST_SM(); }
        ST_BAR(); ST_PV(NT - 1);
    }
#undef ST_BAR
#undef ST_WRITES
#undef ST_PV
#undef ST_QK
#undef ST_SM
    if (hi == 0) li_l[r32] = l_reg; LDS_WAIT();
    float rli[16];
#pragma unroll
    for (int r = 0; r < 16; ++r) rli[r] = __builtin_amdgcn_rcpf(li_l[crow(r, hi)]);
    GAS bf16* Ow = Ob + (size_t)(wid * 32) * LDO;
#pragma unroll
    for (int r = 0; r < 16; ++r) { const int orow = crow(r, hi);
#pragma unroll
        for (int d0 = 0; d0 < 4; ++d0) Ow[(size_t)orow * LDO + d0 * 32 + r32] = (bf16)f2bf(o[d0][r] * rli[r]); }
    LDS_WAIT();
#undef SLOADK
#undef SLOADV
#undef SWRITEK
#undef SWRITEV
}
#undef KSWZ
}

__device__ __forceinline__ void attn_phase(const Frame& F, const gbf16* Q, const gbf16* KN, const gbf16* KR, const gbf16* V, gbf16* AO, int S) {
    for (int k_ = 0; k_ < 4; ++k_) {
        const int ii = (F.bid >> 3) + 32 * k_, h = ii >> 3, r0 = F.xc * 2048 + (ii & 7) * 256, b = r0 / S, qb = (r0 % S) >> 8; const size_t rb = (size_t)b * S;
        att::attn_unit(Q + (rb + (size_t)qb * 256) * 3072 + h * 192, KN + rb * 2048 + h * 128, KR + rb * 64, V + rb * 2048 + h * 128,
                       AO + (rb + (size_t)qb * 256) * 2048 + h * 128, S, F.lds, F.tid);
    }
}

__device__ __forceinline__ int lane_now() { int ln; asm volatile("v_mbcnt_lo_u32_b32 %0, -1, 0\n\tv_mbcnt_hi_u32_b32 %0, -1, %0" : "=v"(ln)); return ln; }
__device__ __forceinline__ int opq(int k) { asm volatile("" : "+s"(k)); return k; }
__device__ __forceinline__ unsigned char* opqp(unsigned char* p) { asm volatile("" : "+s"(p)); return p; }
__device__ __forceinline__ const gf32* opqg(const gf32* p) { asm volatile("" : "+s"(p)); return p; }
__device__ __forceinline__ unsigned* opqu(unsigned* p) { asm volatile("" : "+s"(p)); return p; }
__device__ __forceinline__ Frame make_frame(LAS unsigned char* l, int wave_sgpr) {
    Frame F; int ln = lane_now(); int wv = wave_sgpr; asm volatile("" : "+s"(wv));
    int b = __builtin_amdgcn_readfirstlane(*(volatile LAS int*)(l + MISC_OFF + 14 * 4)); asm volatile("" : "+s"(b)); int G = gridDim.x; asm volatile("" : "+s"(G));
    F.lds = l; F.tid = wv * 64 + ln; F.lane = ln; F.wave = wv; F.G = G; F.bid = b; F.gw = b * NWAVES + wv; F.ngw = G * NWAVES; F.xc = b & 7; F.wx = (b >> 3) * NWAVES + wv; return F; }
#define INP(k) ((const gf32*)args.in[opq(k)])
#define WSP(T, off) ((GAS T*)(w_ + (off)))
#define GEMM_PHASE_MW(EPI, Wgm, Mrows, Aptr, Bptr, Ncols, Kdim, ...) do { pg8::Gemm gm_{Aptr, Bptr, Mrows, Ncols, Kdim}; pg8::StaticOrder So_; So_.init(Mrows, Ncols, F.G, F.bid, Wgm); EPI E_{__VA_ARGS__}; \
    pg8::gemm_phase<EPI, pg8::StaticOrder, true, true>(F.lds + RING_OFF, gm_, So_, E_, F.tid); } while (0)
#define GEMM_PHASE_M(EPI, ...) GEMM_PHASE_MW(EPI, 8, __VA_ARGS__)
#define GEMM_PHASE(EPI, ...) GEMM_PHASE_MW(EPI, 8, MROWS, __VA_ARGS__)
#define M2 (2 * MROWS)
#define PHASE_BEGIN() unsigned char* w_ = opqp(args.ws); const Frame F = make_frame((LAS unsigned char*)lds, wave_id)
#define FOR_ROWS2() _Pragma("unroll 1") for (int it_ = 0; it_ < 16; ++it_) if (const int gg_ = it_ >> 3, m_ = F.xc * 2048 + F.wx + 256 * (it_ & 7), mg_ = gg_ * MROWS + m_; true)


#define GRID_BAR() do { XcdBarrier b2_ = bar; b2_.bar = opqu(b2_.bar); b2_.x = (unsigned)opq((int)b2_.x); { int wv_ = wave_id; asm volatile("" : "+s"(wv_)); int ln_ = lane_now(); b2_.leader = (wv_ == 0 && ln_ == 0); } xcd_barrier(b2_); } while (0)
template <int g> __device__ __forceinline__ void mixer_program(const Args args, unsigned char* lds, const int wave_id, const XcdBarrier bar) {
#define XPTR() ((gf32*)(args.out + (size_t)g * MROWS * D))
#define XNG() (WSP(bf16, WS_XN) + (size_t)g * MROWS * D)
#define SEQ() (g ? 8192 : 2048)
#define SSG() ((gf32*)(w_ + WS_SS + (size_t)g * 196608))
#define SXG(j) ((gf32*)(w_ + WS_SX + (size_t)(j) * 131072 + (size_t)g * 65536))
        { PHASE_BEGIN();
            GEMM_PHASE(pg8::EpiZ, XNG(), WSP(bf16, WS_WIN), INWP, D, WSP(bf16, WS_GU), WSP(bf16, WS_GV), WSP(bf16, WS_QL), WSP(bf16, WS_KVL), WSP(bf16, WS_KR), WSP(bf16, WS_GA), WSP(bf16, WS_GB),
                       WSP(float, WS_COS), WSP(float, WS_SIN), SEQ() - 1, SSG(), SXG(1)); }
        GRID_BAR();
        { PHASE_BEGIN(); gmlp_phase(F, INP(11), INP(12), INP(10), WSP(bf16, WS_GU), WSP(bf16, WS_GV), SSG(), WSP(bf16, WS_GM)); }
        { PHASE_BEGIN(); GEMM_PHASE(pg8::EpiQ, WSP(bf16, WS_QL), WSP(bf16, WS_WUQ), QW, QLR, WSP(bf16, WS_Q), SSG() + 16384, WSP(float, WS_COS), WSP(float, WS_SIN), SEQ() - 1); }
        { PHASE_BEGIN(); GEMM_PHASE(pg8::EpiKV, WSP(bf16, WS_KVL), WSP(bf16, WS_WUKV), KVW, KVR, WSP(bf16, WS_KN), WSP(bf16, WS_V), SSG() + 32768); }
        GRID_BAR();
        { PHASE_BEGIN(); attn_phase(F, WSP(bf16, WS_Q), WSP(bf16, WS_KN), WSP(bf16, WS_KR), WSP(bf16, WS_V), WSP(bf16, WS_AO), SEQ()); }
        GRID_BAR();
        { PHASE_BEGIN(); GEMM_PHASE(pg8::EpiGate<1>, WSP(bf16, WS_GM), WSP(bf16, WS_WOA), D, GMW, WSP(bf16, WS_M1), WSP(bf16, WS_GA), nullptr, D); }
        { PHASE_BEGIN(); GEMM_PHASE(pg8::EpiGate<2>, WSP(bf16, WS_AO), WSP(bf16, WS_WOB), D, NH * 128, WSP(bf16, WS_MG), WSP(bf16, WS_GB), WSP(bf16, WS_M1), D); }
        GRID_BAR();
        { PHASE_BEGIN(); GEMM_PHASE(pg8::EpiResid<false>, WSP(bf16, WS_MG), WSP(bf16, WS_WO), D, D, XNG(), SXG(2)); }
#undef XPTR
#undef XNG
#undef SEQ
#undef SSG
#undef SXG
}

__device__ __forceinline__ void ffn1_program(const Args args, unsigned char* lds, const int wave_id, const XcdBarrier bar) {
        { PHASE_BEGIN(); GEMM_PHASE_M(pg8::EpiSwiGLU, M2, WSP(bf16, WS_XN), WSP(bf16, WS_WF1U), 2 * DFF, D, WSP(bf16, WS_H), DFF, (const gf32*)(w_ + WS_SX)); }
        GRID_BAR();
        { PHASE_BEGIN(); GEMM_PHASE_MW(pg8::EpiResid<true>, 2, M2, WSP(bf16, WS_H), WSP(bf16, WS_WF1D), D, DFF, WSP(bf16, WS_XN), (gf32*)(w_ + WS_SX + 131072)); }
        GRID_BAR();
}
__device__ __forceinline__ void tail_program(const Args args, unsigned char* lds, const int wave_id, const XcdBarrier bar) {
        { PHASE_BEGIN(); GEMM_PHASE_M(pg8::EpiSwiGLU, M2, WSP(bf16, WS_XN), WSP(bf16, WS_WF2U), 2 * DFF, D, WSP(bf16, WS_H), DFF, (const gf32*)(w_ + WS_SX + 2 * 131072)); }
        GRID_BAR();
        { PHASE_BEGIN(); GEMM_PHASE_MW(pg8::EpiResid<true>, 2, M2, WSP(bf16, WS_H), WSP(bf16, WS_WF2D), D, DFF, WSP(bf16, WS_XN), (gf32*)(w_ + WS_SX + 3 * 131072)); }
        GRID_BAR();
        { PHASE_BEGIN(); GEMM_PHASE_M(pg8::EpiGate<0>, M2, WSP(bf16, WS_PB), WSP(bf16, WS_WPP), D, opq(PLE), WSP(bf16, WS_PP), nullptr, nullptr, D); }
        { PHASE_BEGIN(); GEMM_PHASE_M(pg8::EpiPleGate, M2, WSP(bf16, WS_XN), WSP(bf16, WS_WPG), D, D, WSP(bf16, WS_TT), WSP(bf16, WS_PP), D, (GAS float*)(w_ + WS_SST), (const gf32*)(w_ + WS_SX + 3 * 131072)); }
        GRID_BAR();
        { PHASE_BEGIN(); gf32* X = (gf32*)args.out; const gbf16* XR = WSP(bf16, WS_XN); const gbf16* TT = WSP(bf16, WS_TT); const gf32* gp = INP(27); const gf32* gf = INP(28); const gf32* sst = (const gf32*)(w_ + WS_SST);
            FOR_ROWS2() { const int m = mg_;
                const GAS v2u* xr = (const GAS v2u*)(XR + (size_t)m * D) + F.lane; const GAS v2u* tr = (const GAS v2u*)(TT + (size_t)m * D) + F.lane;
                const GAS f32x4* g1 = (const GAS f32x4*)opqg(gp) + F.lane; const GAS f32x4* g2 = (const GAS f32x4*)opqg(gf) + F.lane;
                f32x4 xv[16]; const float rt = 1.0f / sqrtf(sst[m] * (1.f / D) + EPS); float sx = 0.f;
#pragma unroll
                for (int j = 0; j < 16; ++j) { const f32x4 gg = g1[64 * j]; const v2u tw = tr[64 * j]; const f32x4 t = (f32x4){pg8::bf_lo(tw.x), pg8::bf_hi(tw.x), pg8::bf_lo(tw.y), pg8::bf_hi(tw.y)};
                    const v2u xq = xr[64 * j]; xv[j] = (f32x4){pg8::bf_lo(xq.x), pg8::bf_hi(xq.x), pg8::bf_lo(xq.y), pg8::bf_hi(xq.y)} + t * rt * gg; sx += (xv[j].x * xv[j].x + xv[j].y * xv[j].y) + (xv[j].z * xv[j].z + xv[j].w * xv[j].w); }
                const float rx = 1.0f / sqrtf(wave_sum(sx) * (1.f / D) + EPS);
                GAS f32x4* orow = (GAS f32x4*)(X + (size_t)m * D) + F.lane;
#pragma unroll
                for (int j = 0; j < 16; ++j) { const f32x4 gg = g2[64 * j]; orow[64 * j] = xv[j] * rx * gg; }
            } }
}

__global__ void __launch_bounds__(NWAVES * 64, 2) fwd(Args args) {
    extern __shared__ __attribute__((aligned(16))) unsigned char lds[];
    volatile LAS unsigned* MISC = (volatile LAS unsigned*)((LAS unsigned char*)lds + MISC_OFF);
    const int wave_id = __builtin_amdgcn_readfirstlane((int)threadIdx.x >> 6);
    { const int ln0 = lane_now();
      for (int u = wave_id * 64 + ln0; u < (LDS_BYTES - LDSCTL_OFF) / 4; u += NWAVES * 64) ((LAS unsigned*)((LAS unsigned char*)lds + LDSCTL_OFF))[u] = 0u; }
    __syncthreads();
    XcdBarrier bar = xcd_barrier_post((unsigned*)(args.ws + WS_CTL) + CW_BAR, MISC + 8, false);
    if (wave_id == 0 && lane_now() == 0) {
        (void)xb_add(&bar.bar[XB_XCNT(bar.x)], 1u);
        const unsigned rank = xb_add((unsigned*)(args.ws + WS_CTL) + CW_XRANK + 64 * (bar.x & 7u), 1u);
        MISC[12] = bar.x; MISC[13] = rank; MISC[14] = blockIdx.x;
    }
    __syncthreads();

    {
        unsigned char* w_ = opqp(args.ws); const Frame F = make_frame((LAS unsigned char*)lds, wave_id);
        LAS float* scr = (LAS float*)(F.lds + RING_OFF + F.wave * 16384);
        int base = 0;
        tr_matrix<1>(F, INP(5), INP(6), DFF, D, 2 * DFF, WSP(bf16, WS_WF1U), INP(4), scr, base);
        tr_matrix<0>(F, INP(7), nullptr, D, DFF, D, WSP(bf16, WS_WF1D), nullptr, scr, base);
        tr_matrix<1>(F, INP(21), INP(22), DFF, D, 2 * DFF, WSP(bf16, WS_WF2U), INP(20), scr, base);
        tr_matrix<0>(F, INP(23), nullptr, D, DFF, D, WSP(bf16, WS_WF2D), nullptr, scr, base);
        tr_matrix<2>(F, INP(9), nullptr, INW, D, INWP, WSP(bf16, WS_WIN), INP(8), scr, base);
        tr_matrix<0>(F, INP(13), nullptr, D, GMW, D, WSP(bf16, WS_WOA), nullptr, scr, base);
        tr_matrix<0>(F, INP(18), nullptr, D, NH * 128, D, WSP(bf16, WS_WOB), nullptr, scr, base);
        tr_matrix<3>(F, INP(15), nullptr, QW, QLR, QW, WSP(bf16, WS_WUQ), INP(14), scr, base);
        tr_matrix<0>(F, INP(17), nullptr, KVW, KVR, KVW, WSP(bf16, WS_WUKV), INP(16), scr, base);
        tr_matrix<0>(F, INP(19), nullptr, D, D, D, WSP(bf16, WS_WO), nullptr, scr, base);
        tr_matrix<0>(F, INP(25), nullptr, D, D, D, WSP(bf16, WS_WPG), INP(24), scr, base);
        tr_matrix<0>(F, INP(26), nullptr, D, PLE, D, WSP(bf16, WS_WPP), nullptr, scr, base);
        gf32* COS = WSP(float, WS_COS); gf32* SIN = WSP(float, WS_SIN);
        for (int i = F.bid * (NWAVES * 64) + F.tid; i < 8192 * 32; i += F.G * NWAVES * 64) {
            const int s = i >> 5, j = i & 31;
            const float inv = 1.0f / powf(10000.0f, (float)(2 * j) / 64.0f);
            const float ang = (float)s * inv;
            COS[i] = (float)cos((double)ang); SIN[i] = (float)sin((double)ang);
        }
        { const gf32* x0 = INP(0); const gf32* x1 = INP(1); const gf32* p0 = INP(2); const gf32* p1 = INP(3); gbf16* XR = WSP(bf16, WS_XN); gbf16* PB = WSP(bf16, WS_PB); gf32* SX0 = (gf32*)(w_ + WS_SX);
          FOR_ROWS2() { row_to_bf16_ss((gg_ ? x1 : x0) + (size_t)m_ * D, XR + (size_t)mg_ * D, SX0 + mg_, F.lane);
              const f32x4 pv = *((const GAS f32x4*)((gg_ ? p1 : p0) + (size_t)m_ * PLE) + F.lane); v2u w; w.x = pk2(pv.x, pv.y); w.y = pk2(pv.z, pv.w);
              *((GAS v2u*)(PB + (size_t)mg_ * PLE) + F.lane) = w; } }
    }
    GRID_BAR();
    if (wave_id == 0 && lane_now() == 0) {
        unsigned* cw = (unsigned*)(args.ws + WS_CTL) + CW_XRANK; bool ok = (gridDim.x == 256u);
        for (int j = 0; j < 8; ++j) ok = ok && (xb_ld(cw + 64 * j) == 32u);
        const unsigned x = MISC[12], rank = MISC[13];
        MISC[14] = (ok && x < 8u && rank < 32u) ? rank * 8u + x : blockIdx.x;
    }
    __syncthreads();


    ffn1_program(args, lds, wave_id, bar);
    mixer_program<0>(args, lds, wave_id, bar);
    mixer_program<1>(args, lds, wave_id, bar);
    GRID_BAR();
    tail_program(args, lds, wave_id, bar);
#undef GRID_BAR
}

extern "C" void kernel_launch(void* const* d_in, const int* in_sizes, int n_in, void* d_out, int out_size, void* d_ws, size_t ws_size, hipStream_t stream) {
    static int grid = 0;
    if (grid == 0) {
        if (n_in != 29 || in_sizes[0] != MROWS * D || out_size != 2 * MROWS * D || ws_size < WS_END) {
            fprintf(stderr, "kernel_launch: shape mismatch n_in %d in0 %d out %d ws %zu (need %zu)\n", n_in, n_in > 0 ? in_sizes[0] : -1, out_size, ws_size, (size_t)WS_END); grid = -1; return; }
        int dev = 0, cus = 0, per_cu = 0;
        if (hipGetDevice(&dev) != hipSuccess || hipDeviceGetAttribute(&cus, hipDeviceAttributeMultiprocessorCount, dev) != hipSuccess) { grid = -1; return; }
        if (hipFuncSetAttribute((const void*)fwd, hipFuncAttributeMaxDynamicSharedMemorySize, LDS_BYTES) != hipSuccess) { fprintf(stderr, "kernel_launch: hipFuncSetAttribute failed\n"); grid = -1; return; }
        if (hipOccupancyMaxActiveBlocksPerMultiprocessor(&per_cu, (const void*)fwd, NWAVES * 64, LDS_BYTES) != hipSuccess || per_cu < 1)
            fprintf(stderr, "kernel_launch: note: occupancy query reports %d workgroups per CU\n", per_cu);
        (void)hipGetLastError();
        if (cus != 256) { fprintf(stderr, "kernel_launch: built for 256 CUs (one workgroup per CU), device has %d; nothing launched\n", cus); grid = -1; return; }
        grid = cus;
    }
    if (grid < 0) return;
    if (hipMemsetAsync((char*)d_ws + WS_CTL, 0, CTL_ZERO_BYTES, stream) != hipSuccess) { fprintf(stderr, "kernel_launch: memset failed\n"); return; }
    Args a{};
    for (int i = 0; i < 29; ++i) a.in[i] = (const float*)d_in[i];
    a.out = (float*)d_out; a.ws = (unsigned char*)d_ws;
    hipLaunchKernelGGL(fwd, dim3(grid), dim3(NWAVES * 64), LDS_BYTES, stream, a);
    const hipError_t le = hipPeekAtLastError();
    if (le != hipSuccess) fprintf(stderr, "kernel_launch: launch failed: %s\n", hipGetErrorName(le));
}
```

```cpp
#include <hip/hip_runtime.h>
#include <cstdio>
#include <cstdint>


namespace pg8 {
#define PG8_LAS __attribute__((address_space(3)))
#define PG8_GAS __attribute__((address_space(1)))
typedef unsigned short bf16_t;
typedef short bf16x8 __attribute__((ext_vector_type(8)));
typedef float f32x4 __attribute__((ext_vector_type(4)));
typedef unsigned u32x4 __attribute__((ext_vector_type(4)));
typedef unsigned u32x2 __attribute__((ext_vector_type(2)));
constexpr int RS_OFF = 133120;
constexpr int BM = 256, BK = 64, HALF = 128, HTB = HALF * BK * 2  , STAGE_BYTES = 8 * HTB, NXCD = 8, WGM = 8;

__host__ __device__ __forceinline__ int lds_byte(int r, int c) { const int st = (r >> 4) * 2 + (c >> 5), rr = r & 15, cc = c & 31, ob = rr * 64 + cc * 2; return st * 1024 + (ob ^ (((ob >> 9) & 1) << 5)); }
__host__ __device__ __forceinline__ void stage_rc(int b, int& R, int& C) { const int st = b / 1024, sb = b % 1024, swz = sb ^ (((sb >> 9) & 1) << 5); R = (st >> 1) * 16 + swz / 64; C = (st & 1) * 32 + (swz % 64) / 2; }
__host__ __device__ __forceinline__ int perm32(int rho) { const int n = rho >> 4, i = rho & 15; return 8 * (i >> 2) + 4 * n + (i & 3); }

struct Unit { int pm, pn; };
struct Gemm { const PG8_GAS bf16_t* A; const PG8_GAS bf16_t* Bt; int M, N, K; };

struct StaticOrder {
    int nM, nN, nwg, G, c, wgm;
    __host__ __device__ void init(int M, int N, int G_, int c_, int wgm_ = WGM) { nM = M / BM; nN = N / BM; nwg = nM * nN; G = G_; c = c_; wgm = wgm_; }
    __host__ __device__ bool next(int i, Unit& u) const {
        const long L = (long)i * G + c; if (L >= nwg) return false;
        int wgid = (int)L; { const int q = nwg / NXCD, r = nwg % NXCD, xcd = wgid % NXCD, off = wgid / NXCD; wgid = (xcd < r ? xcd * (q + 1) : r * (q + 1) + (xcd - r) * q) + off; }
        const int nig = wgm * nN, gid = wgid / nig, fm = gid * wgm, gsz = (nM - fm) < wgm ? (nM - fm) : wgm;
        u.pm = fm + ((wgid % nig) % gsz); u.pn = (wgid % nig) / gsz; return true;
    }
    __device__ __forceinline__ void a_ready(const Unit&) const {}
    __device__ __forceinline__ void done(const Unit&) const {}
};

__device__ __forceinline__ unsigned cvt_pk_bf16(float lo, float hi) { unsigned r; asm volatile("s_nop 1\n\tv_cvt_pk_bf16_f32 %0, %1, %2" : "=v"(r) : "v"(lo), "v"(hi)); return r; }
__device__ __forceinline__ u32x4 pack8(const f32x4 a, const f32x4 b) { u32x4 w; w.x = cvt_pk_bf16(a[0], a[1]); w.y = cvt_pk_bf16(a[2], a[3]); w.z = cvt_pk_bf16(b[0], b[1]); w.w = cvt_pk_bf16(b[2], b[3]); return w; }
__device__ __forceinline__ float bf_lo(unsigned w) { return __uint_as_float(w << 16); }
__device__ __forceinline__ float bf_hi(unsigned w) { return __uint_as_float(w & 0xffff0000u); }
__device__ __forceinline__ void unpack8(const u32x4 w, f32x4& a, f32x4& b) { a = (f32x4){bf_lo(w.x), bf_hi(w.x), bf_lo(w.y), bf_hi(w.y)}; b = (f32x4){bf_lo(w.z), bf_hi(w.z), bf_lo(w.w), bf_hi(w.w)}; }
__device__ __forceinline__ float sigmoid_f(float x) { return __builtin_amdgcn_rcpf(1.0f + __builtin_amdgcn_exp2f(-1.4426950408889634f * x)); }
__device__ __forceinline__ float silu_f(float x) { return x * sigmoid_f(x); }
__device__ __forceinline__ float gelu_tanh_f(float x) { const float y = 1.5957691216057308f * (x + 0.044715f * x * x * x); return x * sigmoid_f(y); }
__device__ __forceinline__ f32x4 sigmoid4(const f32x4 v) { return (f32x4){sigmoid_f(v[0]), sigmoid_f(v[1]), sigmoid_f(v[2]), sigmoid_f(v[3])}; }
__device__ __forceinline__ f32x4 gelu4(const f32x4 v) { return (f32x4){gelu_tanh_f(v[0]), gelu_tanh_f(v[1]), gelu_tanh_f(v[2]), gelu_tanh_f(v[3])}; }

__device__ __forceinline__ float ssq44(const f32x4 a, const f32x4 b) { return ((a[0] * a[0] + a[1] * a[1]) + (a[2] * a[2] + a[3] * a[3])) + ((b[0] * b[0] + b[1] * b[1]) + (b[2] * b[2] + b[3] * b[3])); }
__device__ __forceinline__ float row4_sum(float s) {
    s += __int_as_float(__builtin_amdgcn_ds_swizzle(__float_as_int(s), (16 << 10) | 0x1f));
    auto rr = __builtin_amdgcn_permlane32_swap(__float_as_uint(s), __float_as_uint(s), false, false); return __uint_as_float(rr[0]) + __uint_as_float(rr[1]); }
__device__ __forceinline__ float rstd_from_ss(float ss, float inv_n) { return __builtin_amdgcn_rsqf(ss * inv_n + 1e-6f); }
__device__ __forceinline__ void atomic_add_row(PG8_GAS float* p, float v) { asm volatile("global_atomic_add_f32 %0, %1, off sc1" :: "v"(p), "v"(v) : "memory"); }
struct EpiSwiGLU {
    static constexpr bool PERM = true, AFTER_DRAIN = false, ROWSCALE = true; static constexpr float INV_N = 1.f / 4096;
    PG8_GAS bf16_t* H; int ldh; const PG8_GAS float* SX;
    __device__ __forceinline__ void operator()(const f32x4 (&acc)[2][2][4][2], const Unit& u, int wr, int wc, int fr, int fq, const PG8_LAS float* rsl) const {
        const int row0 = u.pm * BM + wr * 64 + fr, col0 = u.pn * HALF + wc * 32 + 8 * fq;
#pragma unroll
        for (int ai = 0; ai < 2; ++ai)
#pragma unroll
            for (int m = 0; m < 4; ++m) { const int row = row0 + ai * HALF + m * 16; const float r = rsl[ai * 64 + m * 16 + fr];
                PG8_GAS bf16_t* rowp = H + (size_t)row * ldh + col0;
                const f32x4 g0 = acc[ai][0][m][0] * r, g1 = acc[ai][0][m][1] * r, u0 = acc[ai][1][m][0] * r, u1 = acc[ai][1][m][1] * r;
                const f32x4 v0 = (f32x4){silu_f(g0[0]) * u0[0], silu_f(g0[1]) * u0[1], silu_f(g0[2]) * u0[2], silu_f(g0[3]) * u0[3]};
                const f32x4 v1 = (f32x4){silu_f(g1[0]) * u1[0], silu_f(g1[1]) * u1[1], silu_f(g1[2]) * u1[2], silu_f(g1[3]) * u1[3]};
                *(PG8_GAS u32x4*)rowp = pack8(v0, v1);
            }
    }
};
struct EpiZ {
    static constexpr bool PERM = true, AFTER_DRAIN = false, ROWSCALE = true; static constexpr float INV_N = 1.f / 4096;
    PG8_GAS bf16_t *GU, *GV, *QL, *KVL, *KR, *GA, *GB; const PG8_GAS float* cs; const PG8_GAS float* sn; int smask; PG8_GAS float* SS; const PG8_GAS float* SX;
    __device__ __forceinline__ void operator()(const f32x4 (&acc)[2][2][4][2], const Unit& u, int wr, int wc, int fr, int fq, const PG8_LAS float* rsl) const {
        const int pn = u.pn, row0 = u.pm * BM + wr * 64 + fr, cw = wc * 32 + 8 * fq;
        if (pn < 16) {
            PG8_GAS bf16_t* dst = (pn < 8 ? GU : GV) + (pn & 7) * BM + cw;
#pragma unroll
            for (int ai = 0; ai < 2; ++ai)
#pragma unroll
                for (int m = 0; m < 4; ++m) { const int row = row0 + ai * HALF + m * 16; PG8_GAS bf16_t* rowp = dst + (size_t)row * 2048; float s = 0.f; const float r = rsl[ai * 64 + m * 16 + fr];
#pragma unroll
                    for (int bj = 0; bj < 2; ++bj) { const f32x4 t0 = gelu4(acc[ai][bj][m][0] * r), t1 = gelu4(acc[ai][bj][m][1] * r); s += ssq44(t0, t1); *(PG8_GAS u32x4*)(rowp + bj * HALF) = pack8(t0, t1); }
                    if (pn >= 8) { s = row4_sum(s); if (fq == 0) atomic_add_row(SS + row, s); } }
        } else if (pn < 22) {
            const bool isq = pn < 20; PG8_GAS bf16_t* dst = isq ? QL + (pn - 16) * BM + cw : KVL + (pn - 20) * BM + cw; const int ld = isq ? 1024 : 512;
#pragma unroll
            for (int ai = 0; ai < 2; ++ai)
#pragma unroll
                for (int m = 0; m < 4; ++m) { const int row = row0 + ai * HALF + m * 16; PG8_GAS bf16_t* rowp = dst + (size_t)row * ld; float s = 0.f; const float r = rsl[ai * 64 + m * 16 + fr];
#pragma unroll
                    for (int bj = 0; bj < 2; ++bj) { const f32x4 t0 = acc[ai][bj][m][0] * r, t1 = acc[ai][bj][m][1] * r; s += ssq44(t0, t1); *(PG8_GAS u32x4*)(rowp + bj * HALF) = pack8(t0, t1); }
                    s = row4_sum(s); if (fq == 0) atomic_add_row(SS + (isq ? 16384 : 32768) + row, s); }
        } else if (pn == 22) {
            if (wc == 0) {
#pragma unroll
                for (int ai = 0; ai < 2; ++ai)
#pragma unroll
                    for (int m = 0; m < 4; ++m) { const int row = row0 + ai * HALF + m * 16, s = row & smask;
                        const f32x4 c0 = *(const PG8_GAS f32x4*)(cs + (size_t)s * 32 + 8 * fq), c1 = *(const PG8_GAS f32x4*)(cs + (size_t)s * 32 + 8 * fq + 4);
                        const f32x4 s0 = *(const PG8_GAS f32x4*)(sn + (size_t)s * 32 + 8 * fq), s1 = *(const PG8_GAS f32x4*)(sn + (size_t)s * 32 + 8 * fq + 4);
                        const float r = rsl[ai * 64 + m * 16 + fr];
                        const f32x4 xa = acc[ai][0][m][0] * r, xb = acc[ai][0][m][1] * r, ya = acc[ai][1][m][0] * r, yb = acc[ai][1][m][1] * r;
                        PG8_GAS bf16_t* rowp = KR + (size_t)row * 64 + 8 * fq;
                        *(PG8_GAS u32x4*)rowp = pack8(xa * c0 - ya * s0, xb * c1 - yb * s1);
                        *(PG8_GAS u32x4*)(rowp + 32) = pack8(xa * s0 + ya * c0, xb * s1 + yb * c1); }
            }
        } else {
            const int t = pn - 23; PG8_GAS bf16_t* dst = (t < 16 ? GA : GB) + (t & 15) * BM + cw;
#pragma unroll
            for (int ai = 0; ai < 2; ++ai)
#pragma unroll
                for (int m = 0; m < 4; ++m) { const int row = row0 + ai * HALF + m * 16; PG8_GAS bf16_t* rowp = dst + (size_t)row * 4096; const float r = rsl[ai * 64 + m * 16 + fr];
#pragma unroll
                    for (int bj = 0; bj < 2; ++bj) *(PG8_GAS u32x4*)(rowp + bj * HALF) = pack8(sigmoid4(acc[ai][bj][m][0] * r), sigmoid4(acc[ai][bj][m][1] * r)); }
        }
    }
};
struct EpiQ {
    static constexpr bool PERM = true, AFTER_DRAIN = false, ROWSCALE = true; static constexpr float INV_N = 1.f / 1024;
    PG8_GAS bf16_t* Q; const PG8_GAS float* SX; const PG8_GAS float* cs; const PG8_GAS float* sn; int smask;
    __device__ __forceinline__ void operator()(const f32x4 (&acc)[2][2][4][2], const Unit& u, int wr, int wc, int fr, int fq, const PG8_LAS float* rsl) const {
        const int pn = u.pn, row0 = u.pm * BM + wr * 64 + fr;
        if (pn < 8) {
#pragma unroll
            for (int ai = 0; ai < 2; ++ai)
#pragma unroll
                for (int m = 0; m < 4; ++m) { const int row = row0 + ai * HALF + m * 16; const float r = rsl[ai * 64 + m * 16 + fr];
#pragma unroll
                    for (int bj = 0; bj < 2; ++bj) *(PG8_GAS u32x4*)(Q + (size_t)row * 3072 + (2 * pn + bj) * 192 + wc * 32 + 8 * fq) = pack8(acc[ai][bj][m][0] * r, acc[ai][bj][m][1] * r); }
        } else {
            const int head = 4 * (pn - 8) + wc;
#pragma unroll
            for (int ai = 0; ai < 2; ++ai)
#pragma unroll
                for (int m = 0; m < 4; ++m) { const int row = row0 + ai * HALF + m * 16, s = row & smask; const float r = rsl[ai * 64 + m * 16 + fr];
                    const f32x4 c0 = *(const PG8_GAS f32x4*)(cs + (size_t)s * 32 + 8 * fq), c1 = *(const PG8_GAS f32x4*)(cs + (size_t)s * 32 + 8 * fq + 4);
                    const f32x4 s0 = *(const PG8_GAS f32x4*)(sn + (size_t)s * 32 + 8 * fq), s1 = *(const PG8_GAS f32x4*)(sn + (size_t)s * 32 + 8 * fq + 4);
                    const f32x4 xa = acc[ai][0][m][0] * r, xb = acc[ai][0][m][1] * r, ya = acc[ai][1][m][0] * r, yb = acc[ai][1][m][1] * r;
                    PG8_GAS bf16_t* rowp = Q + (size_t)row * 3072 + head * 192 + 128 + 8 * fq;
                    *(PG8_GAS u32x4*)rowp = pack8(xa * c0 - ya * s0, xb * c1 - yb * s1);
                    *(PG8_GAS u32x4*)(rowp + 32) = pack8(xa * s0 + ya * c0, xb * s1 + yb * c1); }
        }
    }
};
struct EpiKV {
    static constexpr bool PERM = true, AFTER_DRAIN = false, ROWSCALE = true; static constexpr float INV_N = 1.f / 512;
    PG8_GAS bf16_t *KN, *V; const PG8_GAS float* SX;
    __device__ __forceinline__ void operator()(const f32x4 (&acc)[2][2][4][2], const Unit& u, int wr, int wc, int fr, int fq, const PG8_LAS float* rsl) const {
        const int row0 = u.pm * BM + wr * 64 + fr, col0 = u.pn * HALF + wc * 32 + 8 * fq;
#pragma unroll
        for (int ai = 0; ai < 2; ++ai)
#pragma unroll
            for (int m = 0; m < 4; ++m) { const int row = row0 + ai * HALF + m * 16; const float r = rsl[ai * 64 + m * 16 + fr];
                *(PG8_GAS u32x4*)(KN + (size_t)row * 2048 + col0) = pack8(acc[ai][0][m][0] * r, acc[ai][0][m][1] * r);
                *(PG8_GAS u32x4*)(V + (size_t)row * 2048 + col0) = pack8(acc[ai][1][m][0] * r, acc[ai][1][m][1] * r); }
    }
};
template <int MODE> struct EpiGate {
    static constexpr bool PERM = true, AFTER_DRAIN = false, ROWSCALE = false;
    PG8_GAS bf16_t* O; const PG8_GAS bf16_t* G; const PG8_GAS bf16_t* P; int ldc;
    __device__ __forceinline__ void operator()(const f32x4 (&acc)[2][2][4][2], const Unit& u, int wr, int wc, int fr, int fq) const {
        const int row0 = u.pm * BM + wr * 64 + fr, col0 = u.pn * BM + wc * 32 + 8 * fq;
#pragma unroll
        for (int ai = 0; ai < 2; ++ai) {
            u32x4 gin[4][2], pin[4][2];
            if (MODE >= 1) {
#pragma unroll
                for (int m = 0; m < 4; ++m)
#pragma unroll
                    for (int bj = 0; bj < 2; ++bj) { const size_t off = (size_t)(row0 + ai * HALF + m * 16) * ldc + col0 + bj * HALF;
                        gin[m][bj] = *(const PG8_GAS u32x4*)(G + off); if (MODE == 2) pin[m][bj] = *(const PG8_GAS u32x4*)(P + off); }
            }
#pragma unroll
            for (int m = 0; m < 4; ++m)
#pragma unroll
                for (int bj = 0; bj < 2; ++bj) { const size_t off = (size_t)(row0 + ai * HALF + m * 16) * ldc + col0 + bj * HALF; f32x4 v0 = acc[ai][bj][m][0], v1 = acc[ai][bj][m][1];
                    if (MODE >= 1) { f32x4 g0, g1; unpack8(gin[m][bj], g0, g1); v0 = v0 * g0; v1 = v1 * g1; }
                    if (MODE == 2) { f32x4 p0, p1; unpack8(pin[m][bj], p0, p1); v0 = v0 + p0; v1 = v1 + p1; }
                    *(PG8_GAS u32x4*)(O + off) = pack8(v0, v1); }
        }
    }
};
template <bool HALF_ALPHA> struct EpiResid {
    static constexpr bool PERM = true, AFTER_DRAIN = false, ROWSCALE = false;
    PG8_GAS bf16_t* X; PG8_GAS float* SX;
    __device__ __forceinline__ void operator()(const f32x4 (&acc)[2][2][4][2], const Unit& u, int wr, int wc, int fr, int fq) const {
        const int row0 = u.pm * BM + wr * 64 + fr, col0 = u.pn * BM + wc * 32 + 8 * fq; const float alpha = HALF_ALPHA ? 0.5f : 1.0f;
        u32x4 xin[2][4][2];
#pragma unroll
        for (int ai = 0; ai < 2; ++ai)
#pragma unroll
            for (int m = 0; m < 4; ++m)
#pragma unroll
                for (int bj = 0; bj < 2; ++bj) xin[ai][m][bj] = *(const PG8_GAS u32x4*)(X + (size_t)(row0 + ai * HALF + m * 16) * 4096 + col0 + bj * HALF);
#pragma unroll
        for (int ai = 0; ai < 2; ++ai)
#pragma unroll
            for (int m = 0; m < 4; ++m) { const int row = row0 + ai * HALF + m * 16; const size_t off = (size_t)row * 4096 + col0; float s = 0.f;
#pragma unroll
                for (int bj = 0; bj < 2; ++bj) { f32x4 x0, x1; unpack8(xin[ai][m][bj], x0, x1);
                    const f32x4 v0 = x0 + acc[ai][bj][m][0] * alpha, v1 = x1 + acc[ai][bj][m][1] * alpha; s += ssq44(v0, v1);
                    *(PG8_GAS u32x4*)(X + off + bj * HALF) = pack8(v0, v1); }
                s = row4_sum(s); if (fq == 0) atomic_add_row(SX + row, s); }
    }
};
struct EpiPleGate {
    static constexpr bool PERM = true, AFTER_DRAIN = false, ROWSCALE = true; static constexpr float INV_N = 1.f / 4096;
    PG8_GAS bf16_t* TT; const PG8_GAS bf16_t* PP; int ldc; PG8_GAS float* sst; const PG8_GAS float* SX;
    __device__ __forceinline__ void operator()(const f32x4 (&acc)[2][2][4][2], const Unit& u, int wr, int wc, int fr, int fq, const PG8_LAS float* rsl) const {
        const int row0 = u.pm * BM + wr * 64 + fr, col0 = u.pn * BM + wc * 32 + 8 * fq;
        u32x4 pin[2][4][2];
#pragma unroll
        for (int ai = 0; ai < 2; ++ai)
#pragma unroll
            for (int m = 0; m < 4; ++m)
#pragma unroll
                for (int bj = 0; bj < 2; ++bj) pin[ai][m][bj] = *(const PG8_GAS u32x4*)(PP + (size_t)(row0 + ai * HALF + m * 16) * ldc + col0 + bj * HALF);
#pragma unroll
        for (int ai = 0; ai < 2; ++ai)
#pragma unroll
            for (int m = 0; m < 4; ++m) { const int row = row0 + ai * HALF + m * 16; const size_t off = (size_t)row * ldc + col0; float s = 0.f; const float r = rsl[ai * 64 + m * 16 + fr];
#pragma unroll
                for (int bj = 0; bj < 2; ++bj) { f32x4 p0, p1; unpack8(pin[ai][m][bj], p0, p1);
                    const f32x4 t0 = sigmoid4(acc[ai][bj][m][0] * r) * p0, t1 = sigmoid4(acc[ai][bj][m][1] * r) * p1;
                    s += ssq44(t0, t1);
                    *(PG8_GAS u32x4*)(TT + off + bj * HALF) = pack8(t0, t1); }
                s = row4_sum(s); if (fq == 0) atomic_add_row(sst + row, s); }
    }
};

template <class Epi, class Sched, bool ALIGN_EPI = false, bool SP2 = false>
__device__ __forceinline__ void gemm_phase(PG8_LAS unsigned char* lds, const Gemm g, const Sched& S, const Epi& E, const int tid) {
    const int wid = __builtin_amdgcn_readfirstlane(tid >> 6), lane = tid & 63, wr = wid >> 2, wc = wid & 3, fr = lane & 15, fq = lane >> 4;
    const int K = g.K, nt = K / BK;
    unsigned voffA[2], voffB[2];
#pragma unroll
    for (int i = 0; i < 2; ++i) { int R, C; stage_rc(tid * 16 + i * 8192, R, C); const int Rb = Epi::PERM ? ((R & ~31) + perm32(R & 31)) : R;
        voffA[i] = (unsigned)(R * K + C) * 2u; voffB[i] = (unsigned)(Rb * K + C) * 2u; }
    const size_t kstep = (size_t)(BK * 2);
    const size_t hstep = (size_t)HALF * K * 2;
    const size_t tstep = 2 * hstep;
    const unsigned ldsw = (unsigned)wid * 1024u;
    const int aoff = lds_byte(wr * 64 + fr, fq * 8), boff = lds_byte(wc * 32 + fr, fq * 8);
#define PG8_SA(b, h) (((b) * 2 + (h)) * HTB)
#define PG8_SB(b, h) ((4 + (b) * 2 + (h)) * HTB)
#define PG8_STAGE(bufoff, gbase, voff) do { _Pragma("unroll") for (int _i = 0; _i < 2; ++_i) \
        __builtin_amdgcn_global_load_lds((const PG8_GAS unsigned*)((const PG8_GAS char*)(gbase) + (voff)[_i]), (PG8_LAS unsigned*)(lds + (bufoff) + ldsw + _i * 8192), 16, 0, 0); } while (0)
#define PG8_LDA(dst, b, h) do { _Pragma("unroll") for (int m = 0; m < 4; ++m) _Pragma("unroll") for (int k = 0; k < 2; ++k) dst[m][k] = *(const PG8_LAS bf16x8*)(lds + PG8_SA(b, h) + aoff + m * 2048 + k * 1024); } while (0)
#define PG8_LDB(dst, b, h) do { _Pragma("unroll") for (int n = 0; n < 2; ++n) _Pragma("unroll") for (int k = 0; k < 2; ++k) dst[n][k] = *(const PG8_LAS bf16x8*)(lds + PG8_SB(b, h) + boff + n * 2048 + k * 1024); } while (0)
#define PG8_MMA(ai, bj, At, Bt) do { __builtin_amdgcn_s_setprio(1); _Pragma("unroll") for (int m = 0; m < 4; ++m) _Pragma("unroll") for (int n = 0; n < 2; ++n) _Pragma("unroll") for (int k = 0; k < 2; ++k) \
        acc[ai][bj][m][n] = __builtin_amdgcn_mfma_f32_16x16x32_bf16(Bt[n][k], At[m][k], acc[ai][bj][m][n], 0, 0, 0); __builtin_amdgcn_s_setprio(0); } while (0)
#define PG8_WAIT_V(n) asm volatile("s_waitcnt vmcnt(" #n ")" ::: "memory")
#define PG8_WAIT_L(n) asm volatile("s_waitcnt lgkmcnt(" #n ")" ::: "memory")
#define PG8_BAR __builtin_amdgcn_s_barrier()
#define PG8_SCHED __builtin_amdgcn_sched_barrier(0)
    Unit cur, nxt; int ui = 0; int rs_tag = -1;
    if (!S.next(0, cur)) return;
    f32x4 acc[2][2][4][2];
#pragma unroll
    for (int a = 0; a < 2; ++a)
#pragma unroll
        for (int b = 0; b < 2; ++b)
#pragma unroll
            for (int m = 0; m < 4; ++m)
#pragma unroll
                for (int n = 0; n < 2; ++n) acc[a][b][m][n] = (f32x4){0.f, 0.f, 0.f, 0.f};
    bf16x8 At[4][2], B0[2][2], B1[2][2];
    const PG8_GAS char* cA = (const PG8_GAS char*)g.A + (size_t)cur.pm * tstep; const PG8_GAS char* cB = (const PG8_GAS char*)g.Bt + (size_t)cur.pn * tstep;
    S.a_ready(cur);
    if constexpr (SP2) {
        PG8_STAGE(PG8_SB(0, 0), cB, voffB); PG8_STAGE(PG8_SB(0, 1), cB + hstep, voffB); PG8_STAGE(PG8_SA(0, 0), cA, voffA); PG8_STAGE(PG8_SA(0, 1), cA + hstep, voffA);
        if (wr == 1) PG8_BAR;
        PG8_WAIT_V(2); PG8_BAR;
        PG8_STAGE(PG8_SB(1, 0), cB + kstep, voffB); PG8_STAGE(PG8_SA(1, 0), cA + kstep, voffA); PG8_STAGE(PG8_SB(1, 1), cB + hstep + kstep, voffB);
        PG8_WAIT_V(6); PG8_BAR;
    } else {
        PG8_STAGE(PG8_SB(0, 0), cB, voffB); PG8_STAGE(PG8_SA(0, 0), cA, voffA); PG8_STAGE(PG8_SB(0, 1), cB + hstep, voffB); PG8_STAGE(PG8_SA(0, 1), cA + hstep, voffA);
        if (wr == 1) PG8_BAR;
        PG8_WAIT_V(4); PG8_BAR;
        PG8_STAGE(PG8_SB(1, 0), cB + kstep, voffB); PG8_STAGE(PG8_SA(1, 0), cA + kstep, voffA); PG8_STAGE(PG8_SB(1, 1), cB + hstep + kstep, voffB);
        PG8_WAIT_V(6); PG8_BAR;
    }
    for (;;) {
        const bool has_next = S.next(ui + 1, nxt);
        const PG8_GAS char* nA = has_next ? (const PG8_GAS char*)g.A + (size_t)nxt.pm * tstep : cA; const PG8_GAS char* nB = has_next ? (const PG8_GAS char*)g.Bt + (size_t)nxt.pn * tstep : cB;
        for (int t = 0; t < nt; t += 2) {
            const bool last = (t == nt - 2);
            const PG8_GAS char* a1 = cA + (size_t)(t + 1) * kstep;
            const PG8_GAS char* a2 = last ? nA : cA + (size_t)(t + 2) * kstep; const PG8_GAS char* b2 = last ? nB : cB + (size_t)(t + 2) * kstep;
            const PG8_GAS char* a3 = a2 + kstep; const PG8_GAS char* b3 = b2 + kstep;
            if (last && has_next) S.a_ready(nxt);
            if constexpr (SP2) {
            PG8_LDB(B0, 0, 0); PG8_LDB(B1, 0, 1); PG8_SCHED; PG8_LDA(At, 0, 0); PG8_STAGE(PG8_SA(1, 1), a1 + hstep, voffA);
            PG8_WAIT_V(8); PG8_WAIT_L(0); PG8_BAR; PG8_MMA(0, 0, At, B0); PG8_MMA(0, 1, At, B1); PG8_BAR; PG8_SCHED;
            PG8_LDA(At, 0, 1); PG8_STAGE(PG8_SB(0, 0), b2, voffB); PG8_STAGE(PG8_SB(0, 1), b2 + hstep, voffB); PG8_STAGE(PG8_SA(0, 0), a2, voffA);
            PG8_WAIT_V(8); PG8_WAIT_L(0); PG8_BAR; PG8_MMA(1, 0, At, B0); PG8_MMA(1, 1, At, B1); PG8_BAR; PG8_SCHED;
            PG8_LDB(B0, 1, 0); PG8_LDB(B1, 1, 1); PG8_SCHED; PG8_LDA(At, 1, 0); PG8_STAGE(PG8_SA(0, 1), a2 + hstep, voffA);
            PG8_WAIT_V(8); PG8_WAIT_L(0); PG8_BAR; PG8_MMA(0, 0, At, B0); PG8_MMA(0, 1, At, B1); PG8_BAR; PG8_SCHED;
            PG8_LDA(At, 1, 1); PG8_STAGE(PG8_SB(1, 0), b3, voffB); PG8_STAGE(PG8_SB(1, 1), b3 + hstep, voffB); PG8_STAGE(PG8_SA(1, 0), a3, voffA);
            PG8_WAIT_V(8); PG8_WAIT_L(0); PG8_BAR; PG8_MMA(1, 0, At, B0); PG8_MMA(1, 1, At, B1); PG8_BAR; PG8_SCHED;
            } else {
            PG8_LDB(B0, 0, 0); PG8_SCHED; PG8_LDA(At, 0, 0); PG8_STAGE(PG8_SA(1, 1), a1 + hstep, voffA);
            PG8_WAIT_L(8); PG8_BAR; PG8_WAIT_L(0); PG8_MMA(0, 0, At, B0); PG8_BAR; PG8_SCHED;
            PG8_LDB(B1, 0, 1); PG8_STAGE(PG8_SB(0, 0), b2, voffB);
            PG8_BAR; PG8_WAIT_L(0); PG8_MMA(0, 1, At, B1); PG8_BAR;
            PG8_LDA(At, 0, 1); PG8_STAGE(PG8_SA(0, 0), a2, voffA);
            PG8_BAR; PG8_WAIT_L(0); PG8_MMA(1, 0, At, B0); PG8_BAR; PG8_SCHED;
            PG8_STAGE(PG8_SB(0, 1), b2 + hstep, voffB);
            PG8_WAIT_V(6); PG8_BAR; PG8_MMA(1, 1, At, B1); PG8_BAR;
            PG8_LDB(B0, 1, 0); PG8_SCHED; PG8_LDA(At, 1, 0); PG8_STAGE(PG8_SA(0, 1), a2 + hstep, voffA);
            PG8_WAIT_L(8); PG8_BAR; PG8_WAIT_L(0); PG8_MMA(0, 0, At, B0); PG8_BAR; PG8_SCHED;
            PG8_LDB(B1, 1, 1); PG8_STAGE(PG8_SB(1, 0), b3, voffB);
            PG8_BAR; PG8_WAIT_L(0); PG8_MMA(0, 1, At, B1); PG8_BAR;
            PG8_LDA(At, 1, 1); PG8_STAGE(PG8_SA(1, 0), a3, voffA);
            PG8_BAR; PG8_WAIT_L(0); PG8_MMA(1, 0, At, B0); PG8_BAR; PG8_SCHED;
            PG8_STAGE(PG8_SB(1, 1), b3 + hstep, voffB);
            PG8_WAIT_V(6); PG8_BAR; PG8_MMA(1, 1, At, B1); PG8_BAR;
            }
        }
        if constexpr (ALIGN_EPI) { if (wr == 0) PG8_BAR; }
        if constexpr (!Epi::AFTER_DRAIN) {
            if constexpr (Epi::ROWSCALE) {
                PG8_LAS float* rsl = (PG8_LAS float*)(lds + RS_OFF + wid * 512);
                if (cur.pm != rs_tag) { rs_tag = cur.pm; const int rb = cur.pm * BM + wr * 64 + lane; rsl[lane] = rstd_from_ss(E.SX[rb], Epi::INV_N); rsl[64 + lane] = rstd_from_ss(E.SX[rb + HALF], Epi::INV_N); }
                E(acc, cur, wr, wc, fr, fq, rsl);
            } else E(acc, cur, wr, wc, fr, fq);
            S.done(cur); }
        if (!has_next) break;
#pragma unroll
        for (int a = 0; a < 2; ++a)
#pragma unroll
            for (int b = 0; b < 2; ++b)
#pragma unroll
                for (int m = 0; m < 4; ++m)
#pragma unroll
                    for (int n = 0; n < 2; ++n) acc[a][b][m][n] = (f32x4){0.f, 0.f, 0.f, 0.f};
        cur = nxt; cA = nA; cB = nB; ++ui;
        if constexpr (ALIGN_EPI) { if (wr == 1) PG8_BAR; }
    }
    PG8_WAIT_V(0);
    if constexpr (!ALIGN_EPI) { if (wr == 0) PG8_BAR; }
    PG8_BAR;
#undef PG8_SA
#undef PG8_SB
#undef PG8_STAGE
#undef PG8_LDA
#undef PG8_LDB
#undef PG8_MMA
#undef PG8_WAIT_V
#undef PG8_WAIT_L
#undef PG8_BAR
#undef PG8_SCHED
}
}

constexpr int NWAVES = 8;
constexpr int D = 4096, DFF = 11008, MROWS = 16384, NGRP = 2, PLE = 256, GMW = 2048, NH = 16, QLR = 1024, KVR = 512;
constexpr int INW = 13888, INWP = 14080, QW = 3072, KVW = 4096;
constexpr float EPS = 1e-6f;
constexpr size_t MiB = 1u << 20;
constexpr size_t WS_CTL = 0, CTL_ZERO_BYTES = 1152 * 1024;
constexpr size_t WS_COS = 2 * MiB, WS_SIN = 3 * MiB, WS_SS = 256 * 1024;
constexpr size_t WS_WF1U = 8 * MiB, WS_WF1D = WS_WF1U + 172 * MiB, WS_WF2U = WS_WF1D + 86 * MiB, WS_WF2D = WS_WF2U + 172 * MiB;
constexpr size_t WS_WIN = WS_WF2D + 86 * MiB, WS_WOA = WS_WIN + 110 * MiB, WS_WOB = WS_WOA + 16 * MiB, WS_WUQ = WS_WOB + 16 * MiB, WS_WUKV = WS_WUQ + 6 * MiB;
constexpr size_t WS_WO = WS_WUKV + 4 * MiB, WS_WPG = WS_WO + 32 * MiB, WS_WPP = WS_WPG + 32 * MiB, WS_WEND = WS_WPP + 2 * MiB;
static_assert(WS_WEND == 742 * MiB, "weight map");
constexpr size_t WS_XN = 744 * MiB;
constexpr size_t WS_R1 = WS_XN + 256 * MiB;
constexpr size_t WS_H = WS_R1, WS_GU = WS_R1, WS_GV = WS_R1 + 64 * MiB, WS_QL = WS_R1 + 128 * MiB, WS_KVL = WS_R1 + 160 * MiB, WS_KR = WS_R1 + 176 * MiB;
constexpr size_t WS_GA = WS_R1 + 192 * MiB, WS_GB = WS_R1 + 320 * MiB, WS_PP = WS_R1, WS_TT = WS_R1 + 256 * MiB;
constexpr size_t WS_Q = WS_R1 + 448 * MiB, WS_KN = WS_Q + 96 * MiB, WS_M1 = WS_GU, WS_MG = WS_KN, WS_V = WS_KN + 64 * MiB, WS_AO = WS_V + 64 * MiB, WS_GM = WS_AO + 64 * MiB;
constexpr size_t WS_PB = WS_R1 + 800 * MiB;
constexpr size_t WS_END = WS_PB + 16 * MiB;
static_assert((size_t)2 * MROWS * DFF * 2 <= 800 * MiB && WS_GM + 64 * MiB == WS_R1 + 800 * MiB && WS_END == 1816 * MiB, "activation map");
constexpr int CW_BAR = 4096, CW_XRANK = 12288;
constexpr size_t WS_SX = 640 * 1024;
constexpr size_t WS_SST = 65536;
constexpr int RING_OFF = 0, RING_BYTES = 131072;
constexpr int LDSCTL_OFF = RING_BYTES, MISC_OFF = LDSCTL_OFF + 320;
constexpr int LDS_BYTES = 147456;

#define GAS __attribute__((address_space(1)))
#define LAS __attribute__((address_space(3)))
typedef unsigned short bf16;
typedef unsigned v4u __attribute__((ext_vector_type(4)));
typedef unsigned v2u __attribute__((ext_vector_type(2)));
typedef float f32x4 __attribute__((ext_vector_type(4)));
typedef float f32x16 __attribute__((ext_vector_type(16)));
typedef short bf16x8 __attribute__((ext_vector_type(8)));
typedef short s16x4 __attribute__((ext_vector_type(4)));
typedef GAS unsigned gu32;
#define RLX_AGENT __ATOMIC_RELAXED, __HIP_MEMORY_SCOPE_AGENT
#define LDS_WAIT() asm volatile("s_waitcnt lgkmcnt(0)" ::: "memory")
#define VM_WAIT() asm volatile("s_waitcnt vmcnt(0)" ::: "memory")
__device__ __forceinline__ unsigned f2bf(float f) { unsigned u = __builtin_bit_cast(unsigned, f); return (u + 0x7fffu + ((u >> 16) & 1u)) >> 16; }
__device__ __forceinline__ unsigned pk2(float lo, float hi) { return f2bf(lo) | (f2bf(hi) << 16); }

#define XB_TMO      128
#define XB_XCNT(j)  (256  + 64 * (j))
#define XB_XSUB(j)  (1280 + 64 * (j))
#define XB_XGEN(j)  (2304 + 64 * (j))
#define XB_TOP      3328
#define XB_TOPGEN   3392
#define XCD_BAR_WORDS 3456
#define XB_SPIN_CAP (1u << 20)
__device__ __forceinline__ unsigned xb_ld(unsigned* p)              { return __hip_atomic_load(p, __ATOMIC_RELAXED, __HIP_MEMORY_SCOPE_AGENT); }
__device__ __forceinline__ unsigned xb_add(unsigned* p, unsigned v) { return __hip_atomic_fetch_add(p, v, __ATOMIC_RELAXED, __HIP_MEMORY_SCOPE_AGENT); }
__device__ __forceinline__ unsigned xb_xcc_id() { return (unsigned)__builtin_amdgcn_s_getreg((3 << 11) | 20) & 0xFu; }
#define XB_SPIN(cond, bar) do { unsigned _sp = 0; while (cond) { __builtin_amdgcn_s_sleep(1); \
    if ((++_sp & 255u) == 0u) { if (xb_ld(&(bar)[XB_TMO])) break; if (_sp > XB_SPIN_CAP) { atomicAdd(&(bar)[XB_TMO], 1u); break; } } } } while (0)
struct XcdBarrier { unsigned* bar; unsigned x; volatile LAS unsigned* st; bool leader; };
__device__ __forceinline__ XcdBarrier xcd_barrier_post(unsigned* bar, volatile LAS unsigned* st, bool leader) {
    XcdBarrier b; b.bar = bar; b.x = xb_xcc_id(); b.st = st; b.leader = leader;
    if (leader) (void)xb_add(&bar[XB_XCNT(b.x)], 1u);
    return b;
}
__device__ __forceinline__ void xcd_barrier_complete(unsigned* bar, unsigned x, unsigned& nloc, unsigned& nx) {
    const unsigned G = gridDim.x * gridDim.y * gridDim.z;
    unsigned sum, cnt, mine, sp = 0u;
    for (;;) {
        sum = 0u; cnt = 0u; mine = 0u;
#pragma unroll
        for (unsigned j = 0; j < 16; ++j) { const unsigned c = xb_ld(&bar[XB_XCNT(j)]); sum += c; cnt += (c > 0u) ? 1u : 0u; mine = (j == x) ? c : mine; }
        if (sum == G) break;
        __builtin_amdgcn_s_sleep(1);
        if ((++sp & 255u) == 0u) { if (xb_ld(&bar[XB_TMO])) break; if (sp > XB_SPIN_CAP) { atomicAdd(&bar[XB_TMO], 1u); break; } }
    }
    nloc = mine > 0u ? mine : 1u; nx = cnt > 0u ? cnt : 1u;
}
__device__ __forceinline__ void xcd_barrier(const XcdBarrier& b) {
    asm volatile("s_waitcnt vmcnt(0)" ::: "memory");
    __syncthreads();
    if (b.leader) {
        unsigned* bar = b.bar;
        __builtin_amdgcn_s_waitcnt(0);
        unsigned nloc = b.st[0], nx = b.st[1];
        if (nloc == 0u) { xcd_barrier_complete(bar, b.x, nloc, nx); b.st[0] = nloc; b.st[1] = nx; }
        const unsigned old = xb_add(&bar[XB_XSUB(b.x)], 1u);
        const unsigned gen = old / nloc;
        if (old + 1u == (gen + 1u) * nloc) {
            __builtin_amdgcn_fence(__ATOMIC_RELEASE, "agent");
            asm volatile("s_waitcnt vmcnt(0)" ::: "memory");
            const unsigned og = xb_add(&bar[XB_TOP], 1u);
            const unsigned tg = og / nx;
            if (og + 1u == (tg + 1u) * nx) xb_add(&bar[XB_TOPGEN], 1u);
            else XB_SPIN(xb_ld(&bar[XB_TOPGEN]) == tg, bar);
            __builtin_amdgcn_fence(__ATOMIC_ACQUIRE, "agent");
            xb_add(&bar[XB_XGEN(b.x)], 1u);
            asm volatile("s_waitcnt vmcnt(0)" ::: "memory");
        } else {
            XB_SPIN(xb_ld(&bar[XB_XGEN(b.x)]) == gen, bar);
            __builtin_amdgcn_fence(__ATOMIC_ACQUIRE, "agent");
            asm volatile("s_waitcnt vmcnt(0)" ::: "memory");
        }
    }
    __syncthreads();
}

struct Args { const float* in[29]; float* out; unsigned char* ws; };
typedef GAS float gf32; typedef GAS unsigned short gbf16;
struct Frame {
    LAS unsigned char* lds;
    int tid, lane, wave, G, bid, gw, ngw;
    int xc, wx;
};
__device__ __forceinline__ float wave_sum(float v) {
    v += __int_as_float(__builtin_amdgcn_ds_swizzle(__float_as_int(v), (1 << 10) | 0x1f));
    v += __int_as_float(__builtin_amdgcn_ds_swizzle(__float_as_int(v), (2 << 10) | 0x1f));
    v += __int_as_float(__builtin_amdgcn_ds_swizzle(__float_as_int(v), (4 << 10) | 0x1f));
    v += __int_as_float(__builtin_amdgcn_ds_swizzle(__float_as_int(v), (8 << 10) | 0x1f));
    v += __int_as_float(__builtin_amdgcn_ds_swizzle(__float_as_int(v), (16 << 10) | 0x1f));
    auto rr = __builtin_amdgcn_permlane32_swap(__float_as_uint(v), __float_as_uint(v), false, false);
    return __uint_as_float(rr[0]) + __uint_as_float(rr[1]);
}

__device__ __forceinline__ void tr_item(const gf32* W, int ldw, int k0, int n0src, gbf16* WT, int K, int row0dst, const gf32* kscale, LAS float* scr, int lane) {
    f32x4 wv[8];
#pragma unroll
    for (int i = 0; i < 8; ++i) wv[i] = __builtin_nontemporal_load((const GAS f32x4*)(W + (size_t)(k0 + 8 * i + (lane >> 3)) * ldw + n0src + (lane & 7) * 4));
#pragma unroll
    for (int i = 0; i < 8; ++i) { LAS float* d = scr + (8 * i + (lane >> 3)) * 33 + (lane & 7) * 4; d[0] = wv[i].x; d[1] = wv[i].y; d[2] = wv[i].z; d[3] = wv[i].w; }
    LDS_WAIT(); asm volatile("" ::: "memory");
    const int c = lane & 7;
    f32x4 ka = (f32x4){1.f, 1.f, 1.f, 1.f}, kb = ka;
    if (kscale) { ka = *(const GAS f32x4*)(kscale + k0 + 8 * c); kb = *(const GAS f32x4*)(kscale + k0 + 8 * c + 4); }
#pragma unroll
    for (int j = 0; j < 4; ++j) { const int n = (lane >> 3) + 8 * j; const LAS float* s = scr + (8 * c) * 33 + n;
        v4u o; o.x = pk2(s[0 * 33] * ka.x, s[1 * 33] * ka.y); o.y = pk2(s[2 * 33] * ka.z, s[3 * 33] * ka.w); o.z = pk2(s[4 * 33] * kb.x, s[5 * 33] * kb.y); o.w = pk2(s[6 * 33] * kb.z, s[7 * 33] * kb.w);
        *(GAS v4u*)(WT + (size_t)(row0dst + n) * K + k0 + 8 * c) = o; }
    LDS_WAIT(); asm volatile("" ::: "memory");
}
template <int MAP> __device__ __forceinline__ void tr_matrix(const Frame& F, const gf32* W, const gf32* W2, int ldw, int K, int NP, gbf16* WT, const gf32* kscale, LAS float* scr, int& base) {
    const int nkb = K / 64, nnb = NP / 32, nitems = nkb * nnb;
    int it = ((F.gw - base) % F.ngw + F.ngw) % F.ngw;
    for (; it < nitems; it += F.ngw) {
        const int nb = it / nkb, kb = it % nkb, n0 = nb * 32; const gf32* src = W; int c0 = n0;
        if (MAP == 1) { const int t = n0 >> 8, r = n0 & 255; src = (r >= 128) ? W2 : W; c0 = 128 * t + (r & 127); }
        if (MAP == 2) { const int t = n0 >> 8, r = n0 & 255; if (t < 22) c0 = n0; else if (t == 22) c0 = (r == 128) ? 5664 : 5632; else c0 = 5696 + (n0 - 23 * 256); }
        if (MAP == 3) { if (n0 < 2048) { const int t = n0 >> 8, bj = (n0 >> 7) & 1, jj = n0 & 127; c0 = (2 * t + bj) * 192 + jj; }
                        else { const int r = n0 - 2048, t = r >> 8, bj = (r >> 7) & 1, hh = (r >> 5) & 3; c0 = (4 * t + hh) * 192 + 128 + 32 * bj; } }
        tr_item(src, ldw, kb * 64, c0, WT, K, n0, kscale, scr, F.lane);
    }
    base = (base + nitems) % F.ngw;
}

__device__ __forceinline__ void row_to_bf16_ss(const gf32* xrow, gbf16* orow, gf32* ss, int lane) {
    const GAS f32x4* xr = (const GAS f32x4*)xrow + lane; GAS v2u* o8 = (GAS v2u*)orow + lane; float s = 0.f;
#pragma unroll
    for (int j = 0; j < 16; ++j) { const f32x4 v = __builtin_nontemporal_load(xr + 64 * j); s += (v.x * v.x + v.y * v.y) + (v.z * v.z + v.w * v.w); v2u w; w.x = pk2(v.x, v.y); w.y = pk2(v.z, v.w); o8[64 * j] = w; }
    s = wave_sum(s); if (lane == 0) *ss = s;
}
__device__ __forceinline__ float ssq8(const v4u w) {
    const float a = pg8::bf_lo(w.x), b = pg8::bf_hi(w.x), c = pg8::bf_lo(w.y), d = pg8::bf_hi(w.y), e = pg8::bf_lo(w.z), f = pg8::bf_hi(w.z), g = pg8::bf_lo(w.w), h = pg8::bf_hi(w.w);
    return ((a * a + b * b) + (c * c + d * d)) + ((e * e + f * f) + (g * g + h * h));
}

__device__ __forceinline__ void gmlp_phase(const Frame& F, const gf32* ws, const gf32* bs, const gf32* gvn, const gbf16* GU, const gbf16* GV, const gf32* RSV, gbf16* GM) {
    LAS unsigned char* As = F.lds;
    LAS unsigned char* Bs = F.lds + 34816;
    LAS float* rsl = (LAS float*)(F.lds + 69632);
    const int tid = F.tid, lane = F.lane, w = F.wave, fr = lane & 15, fq = lane >> 4;
    const int nitems = (MROWS / 128) * 16;
    (void)nitems;
    for (int k_ = 0; k_ < 8; ++k_) { const int ii = (F.bid >> 3) + 32 * k_;
        const int ch = 16 * F.xc + (ii >> 4), gg = ii & 15, row0 = ch * 128;
        if (tid < 128) rsl[tid] = pg8::rstd_from_ss(RSV[row0 + tid], 1.f / GMW);
        __syncthreads();
#pragma unroll
        for (int i = 0; i < 4; ++i) { const int c = tid + 512 * i, p = c >> 4, q8 = c & 15;
            const f32x4 w0 = *(const GAS f32x4*)(ws + ((size_t)(gg * 128 + p)) * 128 + q8 * 8), w1 = *(const GAS f32x4*)(ws + ((size_t)(gg * 128 + p)) * 128 + q8 * 8 + 4);
            const f32x4 r0 = *(const LAS f32x4*)(rsl + q8 * 8), r1 = *(const LAS f32x4*)(rsl + q8 * 8 + 4);
            *(LAS v4u*)(As + p * 272 + q8 * 16) = pg8::pack8(w0 * r0, w1 * r1); }
#pragma unroll
        for (int i = 0; i < 4; ++i) { const int c = tid + 512 * i, q = c >> 4, c8 = c & 15;
            const v4u v = *(const GAS v4u*)(GV + (size_t)(row0 + q) * GMW + gg * 128 + c8 * 8);
            const int qq = (q ^ (c8 << 3)) * 2; LAS unsigned char* bp = Bs + (c8 * 8) * 272 + qq;
            *(LAS unsigned short*)(bp + 0 * 272) = (unsigned short)(v.x & 0xffffu); *(LAS unsigned short*)(bp + 1 * 272) = (unsigned short)(v.x >> 16);
            *(LAS unsigned short*)(bp + 2 * 272) = (unsigned short)(v.y & 0xffffu); *(LAS unsigned short*)(bp + 3 * 272) = (unsigned short)(v.y >> 16);
            *(LAS unsigned short*)(bp + 4 * 272) = (unsigned short)(v.z & 0xffffu); *(LAS unsigned short*)(bp + 5 * 272) = (unsigned short)(v.z >> 16);
            *(LAS unsigned short*)(bp + 6 * 272) = (unsigned short)(v.w & 0xffffu); *(LAS unsigned short*)(bp + 7 * 272) = (unsigned short)(v.w >> 16); }
        __syncthreads();
        f32x4 acc[8];
#pragma unroll
        for (int ni = 0; ni < 8; ++ni) acc[ni] = (f32x4){0.f, 0.f, 0.f, 0.f};
#pragma unroll
        for (int kb = 0; kb < 4; ++kb) {
            const bf16x8 a = *(const LAS bf16x8*)(As + (16 * w + fr) * 272 + (kb * 32 + fq * 8) * 2);
#pragma unroll
            for (int ni = 0; ni < 8; ++ni) { const int cc = 16 * ni + fr, c8 = cc >> 3;
                const bf16x8 b = *(const LAS bf16x8*)(Bs + cc * 272 + (((kb * 32 + fq * 8) ^ (c8 << 3)) * 2));
                acc[ni] = __builtin_amdgcn_mfma_f32_16x16x32_bf16(b, a, acc[ni], 0, 0, 0); }
        }
        const int row = row0 + 16 * w + fr; const float bsv = bs[gg * 128 + 16 * w + fr];
#pragma unroll
        for (int ni = 0; ni < 8; ++ni) { const int c0 = gg * 128 + 16 * ni + 4 * fq;
            const v2u gu = *(const GAS v2u*)(GU + (size_t)row * GMW + c0); const f32x4 gn = *(const GAS f32x4*)(gvn + c0);
            const float o0 = pg8::bf_lo(gu.x) * (gn[0] * acc[ni][0] + bsv), o1 = pg8::bf_hi(gu.x) * (gn[1] * acc[ni][1] + bsv);
            const float o2 = pg8::bf_lo(gu.y) * (gn[2] * acc[ni][2] + bsv), o3 = pg8::bf_hi(gu.y) * (gn[3] * acc[ni][3] + bsv);
            v2u o; o.x = pg8::cvt_pk_bf16(o0, o1); o.y = pg8::cvt_pk_bf16(o2, o3);
            *(GAS v2u*)(GM + (size_t)row * GMW + c0) = o; }
        __syncthreads();
    }
}

namespace att {
constexpr float SCALE = 0.07216878364870322f;
constexpr float THR = 8.f;
constexpr int SHM_V = 16384, SHM_K = 24576;
constexpr int OFF_V = 0, OFF_K = 2 * SHM_V, OFF_S = OFF_K + 2 * SHM_K;
#define KSWZ(row, colB) ((row) * 384 + ((colB) ^ ((((row) >> 1) & 7) << 4)))
#define SBAR() __builtin_amdgcn_sched_barrier(0)
__device__ __forceinline__ int crow(int r, int hi) { return (r & 3) + 8 * (r >> 2) + 4 * hi; }
__device__ __forceinline__ unsigned cvtpk(float lo, float hi) { unsigned r; asm volatile("s_nop 1\n\tv_cvt_pk_bf16_f32 %0, %1, %2" : "=v"(r) : "v"(lo), "v"(hi)); return r; }
__device__ __forceinline__ void partialSM(f32x16& p0, f32x16& p1, float& m_reg, float& mn, float& alpha) {
    constexpr float C = SCALE * 1.4426950408889634f;
    float pmax = p0[0];
#pragma unroll
    for (int r = 1; r < 16; ++r) pmax = fmaxf(pmax, p0[r]);
#pragma unroll
    for (int r = 0; r < 16; ++r) pmax = fmaxf(pmax, p1[r]);
    { auto rr = __builtin_amdgcn_permlane32_swap(__float_as_uint(pmax), __float_as_uint(pmax), false, false);
      pmax = fmaxf(__uint_as_float(rr[0]), __uint_as_float(rr[1])); }
    if (__builtin_expect(__all(pmax - m_reg <= THR / SCALE), 1)) { mn = m_reg; alpha = 1.f; }
    else { mn = fmaxf(m_reg, pmax); alpha = __builtin_amdgcn_exp2f((m_reg - mn) * C); m_reg = mn; }
    const float mnC = -mn * C;
#pragma unroll
    for (int r = 0; r < 16; ++r) p0[r] = fmaf(p0[r], C, mnC);
#pragma unroll
    for (int r = 0; r < 16; ++r) p1[r] = fmaf(p1[r], C, mnC);
#pragma unroll
    for (int r = 0; r < 16; ++r) p0[r] = __builtin_amdgcn_exp2f(p0[r]);
}
__device__ __forceinline__ void finishSM(f32x16& p0, f32x16& p1, float alpha, float& l_reg, bf16x8& pa0, bf16x8& pa1, bf16x8& pa2, bf16x8& pa3) {
#pragma unroll
    for (int r = 0; r < 16; ++r) p1[r] = __builtin_amdgcn_exp2f(p1[r]);
    float ps = 0;
#pragma unroll
    for (int r = 0; r < 16; ++r) ps += p0[r];
#pragma unroll
    for (int r = 0; r < 16; ++r) ps += p1[r];
    { auto rr = __builtin_amdgcn_permlane32_swap(__float_as_uint(ps), __float_as_uint(ps), false, false);
      ps = __uint_as_float(rr[0]) + __uint_as_float(rr[1]); }
    l_reg = l_reg * alpha + ps;
#define PK4(P, BASE, OUT) do { unsigned a0 = cvtpk(P[BASE + 0], P[BASE + 1]), a1 = cvtpk(P[BASE + 2], P[BASE + 3]);   \
    unsigned b0 = cvtpk(P[BASE + 4], P[BASE + 5]), b1 = cvtpk(P[BASE + 6], P[BASE + 7]);                              \
    auto r0 = __builtin_amdgcn_permlane32_swap(a0, b0, false, false); auto r1 = __builtin_amdgcn_permlane32_swap(a1, b1, false, false); \
    v4u w = {r0[0], r1[0], r0[1], r1[1]}; OUT = __builtin_bit_cast(bf16x8, w); } while (0)
    PK4(p0, 0, pa0); PK4(p0, 8, pa1); PK4(p1, 0, pa2); PK4(p1, 8, pa3);
#undef PK4
}
__device__ __forceinline__ void qkt(f32x16& p0, f32x16& p1, const LAS unsigned char* Ks, const bf16x8 (&qr)[12], int r32, int hi) {
    p0 = f32x16{}; p1 = f32x16{};
    bf16x8 b0 = *(const LAS bf16x8*)(Ks + KSWZ(r32, (hi * 8) * 2)), b1 = *(const LAS bf16x8*)(Ks + KSWZ(32 + r32, (hi * 8) * 2));
#pragma unroll
    for (int d0 = 0; d0 < 12; ++d0) { const int cn = ((d0 + 1) * 16 + hi * 8) * 2; bf16x8 n0 = b0, n1 = b1;
        if (d0 < 11) { n0 = *(const LAS bf16x8*)(Ks + KSWZ(r32, cn)); n1 = *(const LAS bf16x8*)(Ks + KSWZ(32 + r32, cn)); }
        SBAR();
        p0 = __builtin_amdgcn_mfma_f32_32x32x16_bf16(b0, qr[d0], p0, 0, 0, 0);
        p1 = __builtin_amdgcn_mfma_f32_32x32x16_bf16(b1, qr[d0], p1, 0, 0, 0);
        SBAR();
        b0 = n0; b1 = n1; }
}
__device__ __forceinline__ int v_st(int k, int c) { const int kk = (k & ~0xC) | ((k & 4) << 1) | ((k & 8) >> 1); return ((kk >> 3) * 4 + (c >> 5)) * 512 + ((kk & 7) * 32 + (c & 31)) * 2; }
__device__ __forceinline__ int v_rd_base(int lane) { return ((lane & 3) << 3) | (((lane >> 2) & 3) << 6) | (((lane >> 4) & 1) << 5) | (((lane >> 5) & 1) << 8); }
constexpr int v_rd_off(int d0, int ks, int half) { return d0 * 512 + ks * 4096 + half * 2048; }
template <int OFF> __device__ __forceinline__ s16x4 tr_read(int vb) {
    s16x4 r; asm volatile("ds_read_b64_tr_b16 %0, %1 offset:%2" : "=&v"(r) : "v"(vb), "i"(OFF) : "memory"); return r;
}
__device__ __forceinline__ void pv_all(f32x16 (&o)[4], int vb, bf16x8 pa0, bf16x8 pa1, bf16x8 pa2, bf16x8 pa3) {
#define PK(L, H) (bf16x8){L[0], L[1], L[2], L[3], H[0], H[1], H[2], H[3]}
#define TRSET(S, D0) do { S##l0 = tr_read<v_rd_off(D0, 0, 0)>(vb); S##h0 = tr_read<v_rd_off(D0, 0, 1)>(vb); S##l1 = tr_read<v_rd_off(D0, 1, 0)>(vb); S##h1 = tr_read<v_rd_off(D0, 1, 1)>(vb); \
                          S##l2 = tr_read<v_rd_off(D0, 2, 0)>(vb); S##h2 = tr_read<v_rd_off(D0, 2, 1)>(vb); S##l3 = tr_read<v_rd_off(D0, 3, 0)>(vb); S##h3 = tr_read<v_rd_off(D0, 3, 1)>(vb); } while (0)
#define PVMMA(S, od) do { od = __builtin_amdgcn_mfma_f32_32x32x16_bf16(pa0, PK(S##l0, S##h0), od, 0, 0, 0); od = __builtin_amdgcn_mfma_f32_32x32x16_bf16(pa1, PK(S##l1, S##h1), od, 0, 0, 0); \
                          od = __builtin_amdgcn_mfma_f32_32x32x16_bf16(pa2, PK(S##l2, S##h2), od, 0, 0, 0); od = __builtin_amdgcn_mfma_f32_32x32x16_bf16(pa3, PK(S##l3, S##h3), od, 0, 0, 0); } while (0)
#define LWAIT(n) do { asm volatile("s_waitcnt lgkmcnt(" #n ")" ::: "memory"); SBAR(); } while (0)
    s16x4 Al0, Ah0, Al1, Ah1, Al2, Ah2, Al3, Ah3, Bl0, Bh0, Bl1, Bh1, Bl2, Bh2, Bl3, Bh3;
    TRSET(A, 0); TRSET(B, 1); LWAIT(8); PVMMA(A, o[0]); SBAR();
    TRSET(A, 2); LWAIT(8); PVMMA(B, o[1]); SBAR();
    TRSET(B, 3); LWAIT(8); PVMMA(A, o[2]); SBAR();
    LWAIT(0); PVMMA(B, o[3]);
#undef PK
#undef TRSET
#undef PVMMA
#undef LWAIT
}
__device__ __forceinline__ void attn_unit(const gbf16* Qb, const gbf16* Kh, const gbf16* Rh, const gbf16* Vh, gbf16* Ob, int seq, LAS unsigned char* lds, int tid) {
    constexpr int LDQ = 3072, LDK = 2048, LDR = 64, LDO = 2048;
    const int wid = tid >> 6, lane = tid & 63, r32 = lane & 31, hi = lane >> 5;
    LAS unsigned char* V_lds = lds + OFF_V; LAS unsigned char* K_lds = lds + OFF_K;
    LAS float* wsf = (LAS float*)(lds + OFF_S) + wid * 64; LAS float* li_l = wsf; LAS float* al_l = wsf + 32;
    float m_reg = -1e30f, l_reg = 0.f; f32x16 o[4] = {}; bf16x8 qr[12];
    const GAS bf16* Qw = Qb + (size_t)(wid * 32 + r32) * LDQ + hi * 8;
#pragma unroll
    for (int d0 = 0; d0 < 12; ++d0) qr[d0] = *(const GAS bf16x8*)(Qw + d0 * 16);
    const int sr = tid >> 4, sc = (tid & 15) * 8, vst0 = v_st(sr, sc), vst1 = v_st(32 + sr, sc);
    const int rr = tid >> 3, rc = (tid & 7) * 8;
    const int vb0 = (int)(unsigned)(uintptr_t)V_lds + v_rd_base(lane);
    bf16x8 vs0, vs1, ks0, ks1, ks2;
    const unsigned vo_kv = (unsigned)(sr * LDK + sc) * 2u, vo_r = (unsigned)(rr * LDR + rc) * 2u;
#define SLOADK(k0) do { const GAS char* kb_ = (const GAS char*)Kh + (size_t)(k0) * (LDK * 2); const GAS char* rb_ = (const GAS char*)Rh + (size_t)(k0) * (LDR * 2); \
    unsigned o1_ = vo_kv, o2_ = vo_r; asm volatile("" : "+v"(o1_), "+v"(o2_));     \
    ks0 = *(const GAS bf16x8*)(kb_ + o1_); ks1 = *(const GAS bf16x8*)(kb_ + 32 * LDK * 2 + o1_); ks2 = *(const GAS bf16x8*)(rb_ + o2_); } while (0)
#define SLOADV(k0) do { const GAS char* vb_ = (const GAS char*)Vh + (size_t)(k0) * (LDK * 2); unsigned o1_ = vo_kv; asm volatile("" : "+v"(o1_)); \
    vs0 = *(const GAS bf16x8*)(vb_ + o1_); vs1 = *(const GAS bf16x8*)(vb_ + 32 * LDK * 2 + o1_); } while (0)
#define SWRITEK(b) do { *(LAS bf16x8*)(K_lds + (b) * SHM_K + KSWZ(sr, sc * 2)) = ks0; *(LAS bf16x8*)(K_lds + (b) * SHM_K + KSWZ(32 + sr, sc * 2)) = ks1; \
    *(LAS bf16x8*)(K_lds + (b) * SHM_K + KSWZ(rr, 256 + rc * 2)) = ks2; } while (0)
#define SWRITEV(b) do { *(LAS bf16x8*)(V_lds + (b) * SHM_V + vst0) = vs0; *(LAS bf16x8*)(V_lds + (b) * SHM_V + vst1) = vs1; } while (0)
    const int NT = seq / 64, grp = __builtin_amdgcn_readfirstlane(wid >> 2);
    SLOADK(0); SWRITEK(0);
    SLOADK(64); SLOADV(0);
    f32x16 p0, p1; float mn, al; bf16x8 pa0, pa1, pa2, pa3;
#define ST_BAR() do { LDS_WAIT(); __builtin_amdgcn_s_barrier(); asm volatile("" ::: "memory"); } while (0)
#define ST_WRITES(j) do { if ((j) + 1 < NT) SWRITEK(((j) + 1) & 1); SWRITEV((j) & 1); if ((j) + 2 < NT) SLOADK(((j) + 2) * 64); if ((j) + 1 < NT) SLOADV(((j) + 1) * 64); } while (0)
#define ST_PV(j) do { const int vb = vb0 + ((j) & 1) * SHM_V; SBAR(); \
        pv_all(o, vb, pa0, pa1, pa2, pa3); } while (0)
#define ST_QK(j) do { SBAR(); qkt(p0, p1, K_lds + ((j) & 1) * SHM_K, qr, r32, hi); } while (0)
#define ST_SM() do { partialSM(p0, p1, m_reg, mn, al); \
        if (__any(al < 1.f)) { if (hi == 0) al_l[r32] = al; LDS_WAIT(); \
            _Pragma("unroll") for (int d = 0; d < 4; ++d) _Pragma("unroll") for (int r = 0; r < 16; ++r) o[d][r] *= al_l[crow(r, hi)]; } \
        finishSM(p0, p1, al, l_reg, pa0, pa1, pa2, pa3); SBAR(); } while (0)
    if (grp == 0) {
        ST_BAR(); ST_QK(0); ST_BAR(); ST_WRITES(0); ST_SM();
        for (int j = 1; j < NT; ++j) { ST_BAR(); ST_PV(j - 1); ST_QK(j); ST_BAR(); ST_WRITES(j); ST_SM(); }
        ST_BAR(); ST_PV(NT - 1); ST_BAR();
    } else {
        ST_BAR(); ST_BAR(); ST_WRITES(0); ST_QK(0); ST_BAR(); ST_SM();
        for (int j = 1; j < NT; ++j) { ST_BAR(); ST_WRITES(j); ST_PV(j - 1); ST_QK(j); ST_BAR(); ST_SM(); }
        ST_BAR(); ST_PV(NT - 1);
    }
#undef ST_BAR
#undef ST_WRITES
#undef ST_PV
#undef ST_QK
#undef ST_SM
    if (hi == 0) li_l[r32] = l_reg; LDS_WAIT();
    float rli[16];
#pragma unroll
    for (int r = 0; r < 16; ++r) rli[r] = __builtin_amdgcn_rcpf(li_l[crow(r, hi)]);
    GAS bf16* Ow = Ob + (size_t)(wid * 32) * LDO;
#pragma unroll
    for (int r = 0; r < 16; ++r) { const int orow = crow(r, hi);
#pragma unroll
        for (int d0 = 0; d0 < 4; ++d0) Ow[(size_t)orow * LDO + d0 * 32 + r32] = (bf16)f2bf(o[d0][r] * rli[r]); }
    LDS_WAIT();
#undef SLOADK
#undef SLOADV
#undef SWRITEK
#undef SWRITEV
}
#undef KSWZ
}

__device__ __forceinline__ void attn_phase(const Frame& F, const gbf16* Q, const gbf16* KN, const gbf16* KR, const gbf16* V, gbf16* AO, int S) {
    for (int k_ = 0; k_ < 4; ++k_) {
        const int ii = (F.bid >> 3) + 32 * k_, h = ii >> 3, r0 = F.xc * 2048 + (ii & 7) * 256, b = r0 / S, qb = (r0 % S) >> 8; const size_t rb = (size_t)b * S;
        att::attn_unit(Q + (rb + (size_t)qb * 256) * 3072 + h * 192, KN + rb * 2048 + h * 128, KR + rb * 64, V + rb * 2048 + h * 128,
                       AO + (rb + (size_t)qb * 256) * 2048 + h * 128, S, F.lds, F.tid);
    }
}

__device__ __forceinline__ int lane_now() { int ln; asm volatile("v_mbcnt_lo_u32_b32 %0, -1, 0\n\tv_mbcnt_hi_u32_b32 %0, -1, %0" : "=v"(ln)); return ln; }
__device__ __forceinline__ int opq(int k) { asm volatile("" : "+s"(k)); return k; }
__device__ __forceinline__ unsigned char* opqp(unsigned char* p) { asm volatile("" : "+s"(p)); return p; }
__device__ __forceinline__ const gf32* opqg(const gf32* p) { asm volatile("" : "+s"(p)); return p; }
__device__ __forceinline__ unsigned* opqu(unsigned* p) { asm volatile("" : "+s"(p)); return p; }
__device__ __forceinline__ Frame make_frame(LAS unsigned char* l, int wave_sgpr) {
    Frame F; int ln = lane_now(); int wv = wave_sgpr; asm volatile("" : "+s"(wv));
    int b = __builtin_amdgcn_readfirstlane(*(volatile LAS int*)(l + MISC_OFF + 14 * 4)); asm volatile("" : "+s"(b)); int G = gridDim.x; asm volatile("" : "+s"(G));
    F.lds = l; F.tid = wv * 64 + ln; F.lane = ln; F.wave = wv; F.G = G; F.bid = b; F.gw = b * NWAVES + wv; F.ngw = G * NWAVES; F.xc = b & 7; F.wx = (b >> 3) * NWAVES + wv; return F; }
#define INP(k) ((const gf32*)args.in[opq(k)])
#define WSP(T, off) ((GAS T*)(w_ + (off)))
#define GEMM_PHASE_MW(EPI, Wgm, Mrows, Aptr, Bptr, Ncols, Kdim, ...) do { pg8::Gemm gm_{Aptr, Bptr, Mrows, Ncols, Kdim}; pg8::StaticOrder So_; So_.init(Mrows, Ncols, F.G, F.bid, Wgm); EPI E_{__VA_ARGS__}; \
    pg8::gemm_phase<EPI, pg8::StaticOrder, true, true>(F.lds + RING_OFF, gm_, So_, E_, F.tid); } while (0)
#define GEMM_PHASE_M(EPI, ...) GEMM_PHASE_MW(EPI, 8, __VA_ARGS__)
#define GEMM_PHASE(EPI, ...) GEMM_PHASE_MW(EPI, 8, MROWS, __VA_ARGS__)
#define M2 (2 * MROWS)
#define PHASE_BEGIN() unsigned char* w_ = opqp(args.ws); const Frame F = make_frame((LAS unsigned char*)lds, wave_id)
#define FOR_ROWS2() _Pragma("unroll 1") for (int it_ = 0; it_ < 16; ++it_) if (const int gg_ = it_ >> 3, m_ = F.xc * 2048 + F.wx + 256 * (it_ & 7), mg_ = gg_ * MROWS + m_; true)


#define GRID_BAR() do { XcdBarrier b2_ = bar; b2_.bar = opqu(b2_.bar); b2_.x = (unsigned)opq((int)b2_.x); { int wv_ = wave_id; asm volatile("" : "+s"(wv_)); int ln_ = lane_now(); b2_.leader = (wv_ == 0 && ln_ == 0); } xcd_barrier(b2_); } while (0)
template <int g> __device__ __forceinline__ void mixer_program(const Args args, unsigned char* lds, const int wave_id, const XcdBarrier bar) {
#define XPTR() ((gf32*)(args.out + (size_t)g * MROWS * D))
#define XNG() (WSP(bf16, WS_XN) + (size_t)g * MROWS * D)
#define SEQ() (g ? 8192 : 2048)
#define SSG() ((gf32*)(w_ + WS_SS + (size_t)g * 196608))
#define SXG(j) ((gf32*)(w_ + WS_SX + (size_t)(j) * 131072 + (size_t)g * 65536))
        { PHASE_BEGIN();
            GEMM_PHASE(pg8::EpiZ, XNG(), WSP(bf16, WS_WIN), INWP, D, WSP(bf16, WS_GU), WSP(bf16, WS_GV), WSP(bf16, WS_QL), WSP(bf16, WS_KVL), WSP(bf16, WS_KR), WSP(bf16, WS_GA), WSP(bf16, WS_GB),
                       WSP(float, WS_COS), WSP(float, WS_SIN), SEQ() - 1, SSG(), SXG(1)); }
        GRID_BAR();
        { PHASE_BEGIN(); gmlp_phase(F, INP(11), INP(12), INP(10), WSP(bf16, WS_GU), WSP(bf16, WS_GV), SSG(), WSP(bf16, WS_GM)); }
        { PHASE_BEGIN(); GEMM_PHASE(pg8::EpiQ, WSP(bf16, WS_QL), WSP(bf16, WS_WUQ), QW, QLR, WSP(bf16, WS_Q), SSG() + 16384, WSP(float, WS_COS), WSP(float, WS_SIN), SEQ() - 1); }
        { PHASE_BEGIN(); GEMM_PHASE(pg8::EpiKV, WSP(bf16, WS_KVL), WSP(bf16, WS_WUKV), KVW, KVR, WSP(bf16, WS_KN), WSP(bf16, WS_V), SSG() + 32768); }
        GRID_BAR();
        { PHASE_BEGIN(); attn_phase(F, WSP(bf16, WS_Q), WSP(bf16, WS_KN), WSP(bf16, WS_KR), WSP(bf16, WS_V), WSP(bf16, WS_AO), SEQ()); }
        GRID_BAR();
        { PHASE_BEGIN(); GEMM_PHASE(pg8::EpiGate<1>, WSP(bf16, WS_GM), WSP(bf16, WS_WOA), D, GMW, WSP(bf16, WS_M1), WSP(bf16, WS_GA), nullptr, D); }
        { PHASE_BEGIN(); GEMM_PHASE(pg8::EpiGate<2>, WSP(bf16, WS_AO), WSP(bf16, WS_WOB), D, NH * 128, WSP(bf16, WS_MG), WSP(bf16, WS_GB), WSP(bf16, WS_M1), D); }
        GRID_BAR();
        { PHASE_BEGIN(); GEMM_PHASE(pg8::EpiResid<false>, WSP(bf16, WS_MG), WSP(bf16, WS_WO), D, D, XNG(), SXG(2)); }
#undef XPTR
#undef XNG
#undef SEQ
#undef SSG
#undef SXG
}

__device__ __forceinline__ void ffn1_program(const Args args, unsigned char* lds, const int wave_id, const XcdBarrier bar) {
        { PHASE_BEGIN(); GEMM_PHASE_M(pg8::EpiSwiGLU, M2, WSP(bf16, WS_XN), WSP(bf16, WS_WF1U), 2 * DFF, D, WSP(bf16, WS_H), DFF, (const gf32*)(w_ + WS_SX)); }
        GRID_BAR();
        { PHASE_BEGIN(); GEMM_PHASE_MW(pg8::EpiResid<true>, 2, M2, WSP(bf16, WS_H), WSP(bf16, WS_WF1D), D, DFF, WSP(bf16, WS_XN), (gf32*)(w_ + WS_SX + 131072)); }
        GRID_BAR();
}
__device__ __forceinline__ void tail_program(const Args args, unsigned char* lds, const int wave_id, const XcdBarrier bar) {
        { PHASE_BEGIN(); GEMM_PHASE_M(pg8::EpiSwiGLU, M2, WSP(bf16, WS_XN), WSP(bf16, WS_WF2U), 2 * DFF, D, WSP(bf16, WS_H), DFF, (const gf32*)(w_ + WS_SX + 2 * 131072)); }
        GRID_BAR();
        { PHASE_BEGIN(); GEMM_PHASE_MW(pg8::EpiResid<true>, 2, M2, WSP(bf16, WS_H), WSP(bf16, WS_WF2D), D, DFF, WSP(bf16, WS_XN), (gf32*)(w_ + WS_SX + 3 * 131072)); }
        GRID_BAR();
        { PHASE_BEGIN(); GEMM_PHASE_M(pg8::EpiGate<0>, M2, WSP(bf16, WS_PB), WSP(bf16, WS_WPP), D, opq(PLE), WSP(bf16, WS_PP), nullptr, nullptr, D); }
        { PHASE_BEGIN(); GEMM_PHASE_M(pg8::EpiPleGate, M2, WSP(bf16, WS_XN), WSP(bf16, WS_WPG), D, D, WSP(bf16, WS_TT), WSP(bf16, WS_PP), D, (GAS float*)(w_ + WS_SST), (const gf32*)(w_ + WS_SX + 3 * 131072)); }
        GRID_BAR();
        { PHASE_BEGIN(); gf32* X = (gf32*)args.out; const gbf16* XR = WSP(bf16, WS_XN); const gbf16* TT = WSP(bf16, WS_TT); const gf32* gp = INP(27); const gf32* gf = INP(28); const gf32* sst = (const gf32*)(w_ + WS_SST);
            FOR_ROWS2() { const int m = mg_;
                const GAS v2u* xr = (const GAS v2u*)(XR + (size_t)m * D) + F.lane; const GAS v2u* tr = (const GAS v2u*)(TT + (size_t)m * D) + F.lane;
                const GAS f32x4* g1 = (const GAS f32x4*)opqg(gp) + F.lane; const GAS f32x4* g2 = (const GAS f32x4*)opqg(gf) + F.lane;
                f32x4 xv[16]; const float rt = 1.0f / sqrtf(sst[m] * (1.f / D) + EPS); float sx = 0.f;
#pragma unroll
                for (int j = 0; j < 16; ++j) { const f32x4 gg = g1[64 * j]; const v2u tw = __builtin_nontemporal_load(tr + 64 * j); const f32x4 t = (f32x4){pg8::bf_lo(tw.x), pg8::bf_hi(tw.x), pg8::bf_lo(tw.y), pg8::bf_hi(tw.y)};
                    const v2u xq = __builtin_nontemporal_load(xr + 64 * j); xv[j] = (f32x4){pg8::bf_lo(xq.x), pg8::bf_hi(xq.x), pg8::bf_lo(xq.y), pg8::bf_hi(xq.y)} + t * rt * gg; sx += (xv[j].x * xv[j].x + xv[j].y * xv[j].y) + (xv[j].z * xv[j].z + xv[j].w * xv[j].w); }
                const float rx = 1.0f / sqrtf(wave_sum(sx) * (1.f / D) + EPS);
                GAS f32x4* orow = (GAS f32x4*)(X + (size_t)m * D) + F.lane;
#pragma unroll
                for (int j = 0; j < 16; ++j) { const f32x4 gg = g2[64 * j]; __builtin_nontemporal_store(xv[j] * rx * gg, orow + 64 * j); }
            } }
}

__global__ void __launch_bounds__(NWAVES * 64, 2) fwd(Args args) {
    extern __shared__ __attribute__((aligned(16))) unsigned char lds[];
    volatile LAS unsigned* MISC = (volatile LAS unsigned*)((LAS unsigned char*)lds + MISC_OFF);
    const int wave_id = __builtin_amdgcn_readfirstlane((int)threadIdx.x >> 6);
    { const int ln0 = lane_now();
      for (int u = wave_id * 64 + ln0; u < (LDS_BYTES - LDSCTL_OFF) / 4; u += NWAVES * 64) ((LAS unsigned*)((LAS unsigned char*)lds + LDSCTL_OFF))[u] = 0u; }
    __syncthreads();
    XcdBarrier bar = xcd_barrier_post((unsigned*)(args.ws + WS_CTL) + CW_BAR, MISC + 8, false);
    if (wave_id == 0 && lane_now() == 0) {
        (void)xb_add(&bar.bar[XB_XCNT(bar.x)], 1u);
        const unsigned rank = xb_add((unsigned*)(args.ws + WS_CTL) + CW_XRANK + 64 * (bar.x & 7u), 1u);
        MISC[12] = bar.x; MISC[13] = rank; MISC[14] = blockIdx.x;
    }
    __syncthreads();

    {
        unsigned char* w_ = opqp(args.ws); const Frame F = make_frame((LAS unsigned char*)lds, wave_id);
        LAS float* scr = (LAS float*)(F.lds + RING_OFF + F.wave * 16384);
        int base = 0;
        tr_matrix<1>(F, INP(5), INP(6), DFF, D, 2 * DFF, WSP(bf16, WS_WF1U), INP(4), scr, base);
        tr_matrix<0>(F, INP(7), nullptr, D, DFF, D, WSP(bf16, WS_WF1D), nullptr, scr, base);
        tr_matrix<1>(F, INP(21), INP(22), DFF, D, 2 * DFF, WSP(bf16, WS_WF2U), INP(20), scr, base);
        tr_matrix<0>(F, INP(23), nullptr, D, DFF, D, WSP(bf16, WS_WF2D), nullptr, scr, base);
        tr_matrix<2>(F, INP(9), nullptr, INW, D, INWP, WSP(bf16, WS_WIN), INP(8), scr, base);
        tr_matrix<0>(F, INP(13), nullptr, D, GMW, D, WSP(bf16, WS_WOA), nullptr, scr, base);
        tr_matrix<0>(F, INP(18), nullptr, D, NH * 128, D, WSP(bf16, WS_WOB), nullptr, scr, base);
        tr_matrix<3>(F, INP(15), nullptr, QW, QLR, QW, WSP(bf16, WS_WUQ), INP(14), scr, base);
        tr_matrix<0>(F, INP(17), nullptr, KVW, KVR, KVW, WSP(bf16, WS_WUKV), INP(16), scr, base);
        tr_matrix<0>(F, INP(19), nullptr, D, D, D, WSP(bf16, WS_WO), nullptr, scr, base);
        tr_matrix<0>(F, INP(25), nullptr, D, D, D, WSP(bf16, WS_WPG), INP(24), scr, base);
        tr_matrix<0>(F, INP(26), nullptr, D, PLE, D, WSP(bf16, WS_WPP), nullptr, scr, base);
        gf32* COS = WSP(float, WS_COS); gf32* SIN = WSP(float, WS_SIN);
        for (int i = F.bid * (NWAVES * 64) + F.tid; i < 8192 * 32; i += F.G * NWAVES * 64) {
            const int s = i >> 5, j = i & 31;
            const float inv = 1.0f / powf(10000.0f, (float)(2 * j) / 64.0f);
            const float ang = (float)s * inv;
            COS[i] = (float)cos((double)ang); SIN[i] = (float)sin((double)ang);
        }
        { const gf32* x0 = INP(0); const gf32* x1 = INP(1); const gf32* p0 = INP(2); const gf32* p1 = INP(3); gbf16* XR = WSP(bf16, WS_XN); gbf16* PB = WSP(bf16, WS_PB); gf32* SX0 = (gf32*)(w_ + WS_SX);
          FOR_ROWS2() { row_to_bf16_ss((gg_ ? x1 : x0) + (size_t)m_ * D, XR + (size_t)mg_ * D, SX0 + mg_, F.lane);
              const f32x4 pv = *((const GAS f32x4*)((gg_ ? p1 : p0) + (size_t)m_ * PLE) + F.lane); v2u w; w.x = pk2(pv.x, pv.y); w.y = pk2(pv.z, pv.w);
              *((GAS v2u*)(PB + (size_t)mg_ * PLE) + F.lane) = w; } }
    }
    GRID_BAR();
    if (wave_id == 0 && lane_now() == 0) {
        unsigned* cw = (unsigned*)(args.ws + WS_CTL) + CW_XRANK; bool ok = (gridDim.x == 256u);
        for (int j = 0; j < 8; ++j) ok = ok && (xb_ld(cw + 64 * j) == 32u);
        const unsigned x = MISC[12], rank = MISC[13];
        MISC[14] = (ok && x < 8u && rank < 32u) ? rank * 8u + x : blockIdx.x;
    }
    __syncthreads();


    ffn1_program(args, lds, wave_id, bar);
    mixer_program<0>(args, lds, wave_id, bar);
    mixer_program<1>(args, lds, wave_id, bar);
    GRID_BAR();
    tail_program(args, lds, wave_id, bar);
#undef GRID_BAR
}

extern "C" void kernel_launch(void* const* d_in, const int* in_sizes, int n_in, void* d_out, int out_size, void* d_ws, size_t ws_size, hipStream_t stream) {
    static int grid = 0;
    if (grid == 0) {
        if (n_in != 29 || in_sizes[0] != MROWS * D || out_size != 2 * MROWS * D || ws_size < WS_END) {
            fprintf(stderr, "kernel_launch: shape mismatch n_in %d in0 %d out %d ws %zu (need %zu)\n", n_in, n_in > 0 ? in_sizes[0] : -1, out_size, ws_size, (size_t)WS_END); grid = -1; return; }
        int dev = 0, cus = 0, per_cu = 0;
        if (hipGetDevice(&dev) != hipSuccess || hipDeviceGetAttribute(&cus, hipDeviceAttributeMultiprocessorCount, dev) != hipSuccess) { grid = -1; return; }
        if (hipFuncSetAttribute((const void*)fwd, hipFuncAttributeMaxDynamicSharedMemorySize, LDS_BYTES) != hipSuccess) { fprintf(stderr, "kernel_launch: hipFuncSetAttribute failed\n"); grid = -1; return; }
        if (hipOccupancyMaxActiveBlocksPerMultiprocessor(&per_cu, (const void*)fwd, NWAVES * 64, LDS_BYTES) != hipSuccess || per_cu < 1)
            fprintf(stderr, "kernel_launch: note: occupancy query reports %d workgroups per CU\n", per_cu);
        (void)hipGetLastError();
        if (cus != 256) { fprintf(stderr, "kernel_launch: built for 256 CUs (one workgroup per CU), device has %d; nothing launched\n", cus); grid = -1; return; }
        grid = cus;
    }
    if (grid < 0) return;
    if (hipMemsetAsync((char*)d_ws + WS_CTL, 0, CTL_ZERO_BYTES, stream) != hipSuccess) { fprintf(stderr, "kernel_launch: memset failed\n"); return; }
    Args a{};
    for (int i = 0; i < 29; ++i) a.in[i] = (const float*)d_in[i];
    a.out = (float*)d_out; a.ws = (unsigned char*)d_ws;
    hipLaunchKernelGGL(fwd, dim3(grid), dim3(NWAVES * 64), LDS_BYTES, stream, a);
    const hipError_t le = hipPeekAtLastError();
    if (le != hipSuccess) fprintf(stderr, "kernel_launch: launch failed: %s\n", hipGetErrorName(le));
}
```

```cpp
#include <hip/hip_runtime.h>
#include <cstdio>
#include <cstdint>


namespace pg8 {
#define PG8_LAS __attribute__((address_space(3)))
#define PG8_GAS __attribute__((address_space(1)))
typedef unsigned short bf16_t;
typedef short bf16x8 __attribute__((ext_vector_type(8)));
typedef float f32x4 __attribute__((ext_vector_type(4)));
typedef unsigned u32x4 __attribute__((ext_vector_type(4)));
typedef unsigned u32x2 __attribute__((ext_vector_type(2)));
constexpr int RS_OFF = 133120;
constexpr int BM = 256, BK = 64, HALF = 128, HTB = HALF * BK * 2  , STAGE_BYTES = 8 * HTB, NXCD = 8, WGM = 8;

__host__ __device__ __forceinline__ int lds_byte(int r, int c) { const int st = (r >> 4) * 2 + (c >> 5), rr = r & 15, cc = c & 31, ob = rr * 64 + cc * 2; return st * 1024 + (ob ^ (((ob >> 9) & 1) << 5)); }
__host__ __device__ __forceinline__ void stage_rc(int b, int& R, int& C) { const int st = b / 1024, sb = b % 1024, swz = sb ^ (((sb >> 9) & 1) << 5); R = (st >> 1) * 16 + swz / 64; C = (st & 1) * 32 + (swz % 64) / 2; }
__host__ __device__ __forceinline__ int perm32(int rho) { const int n = rho >> 4, i = rho & 15; return 8 * (i >> 2) + 4 * n + (i & 3); }

struct Unit { int pm, pn; };
struct Gemm { const PG8_GAS bf16_t* A; const PG8_GAS bf16_t* Bt; int M, N, K; };

struct StaticOrder {
    int nM, nN, nwg, G, c, wgm;
    __host__ __device__ void init(int M, int N, int G_, int c_, int wgm_ = WGM) { nM = M / BM; nN = N / BM; nwg = nM * nN; G = G_; c = c_; wgm = wgm_; }
    __host__ __device__ bool next(int i, Unit& u) const {
        const long L = (long)i * G + c; if (L >= nwg) return false;
        int wgid = (int)L; { const int q = nwg / NXCD, r = nwg % NXCD, xcd = wgid % NXCD, off = wgid / NXCD; wgid = (xcd < r ? xcd * (q + 1) : r * (q + 1) + (xcd - r) * q) + off; }
        const int nig = wgm * nN, gid = wgid / nig, fm = gid * wgm, gsz = (nM - fm) < wgm ? (nM - fm) : wgm;
        u.pm = fm + ((wgid % nig) % gsz); u.pn = (wgid % nig) / gsz; return true;
    }
    __device__ __forceinline__ void a_ready(const Unit&) const {}
    __device__ __forceinline__ void done(const Unit&) const {}
};

typedef __bf16 bf16v2_t __attribute__((ext_vector_type(2)));
typedef float f32v2_t __attribute__((ext_vector_type(2)));
__device__ __forceinline__ unsigned cvt_pk_bf16(float lo, float hi) { const f32v2_t v = {lo, hi}; return __builtin_bit_cast(unsigned, __builtin_convertvector(v, bf16v2_t)); }
__device__ __forceinline__ u32x4 pack8(const f32x4 a, const f32x4 b) { u32x4 w; w.x = cvt_pk_bf16(a[0], a[1]); w.y = cvt_pk_bf16(a[2], a[3]); w.z = cvt_pk_bf16(b[0], b[1]); w.w = cvt_pk_bf16(b[2], b[3]); return w; }
__device__ __forceinline__ float bf_lo(unsigned w) { return __uint_as_float(w << 16); }
__device__ __forceinline__ float bf_hi(unsigned w) { return __uint_as_float(w & 0xffff0000u); }
__device__ __forceinline__ void unpack8(const u32x4 w, f32x4& a, f32x4& b) { a = (f32x4){bf_lo(w.x), bf_hi(w.x), bf_lo(w.y), bf_hi(w.y)}; b = (f32x4){bf_lo(w.z), bf_hi(w.z), bf_lo(w.w), bf_hi(w.w)}; }
__device__ __forceinline__ float sigmoid_f(float x) { return __builtin_amdgcn_rcpf(1.0f + __builtin_amdgcn_exp2f(-1.4426950408889634f * x)); }
__device__ __forceinline__ float silu_f(float x) { return x * sigmoid_f(x); }
__device__ __forceinline__ float gelu_tanh_f(float x) { const float y = 1.5957691216057308f * (x + 0.044715f * x * x * x); return x * sigmoid_f(y); }
__device__ __forceinline__ f32x4 sigmoid4(const f32x4 v) { return (f32x4){sigmoid_f(v[0]), sigmoid_f(v[1]), sigmoid_f(v[2]), sigmoid_f(v[3])}; }
__device__ __forceinline__ f32x4 gelu4(const f32x4 v) { return (f32x4){gelu_tanh_f(v[0]), gelu_tanh_f(v[1]), gelu_tanh_f(v[2]), gelu_tanh_f(v[3])}; }

__device__ __forceinline__ float ssq44(const f32x4 a, const f32x4 b) { return ((a[0] * a[0] + a[1] * a[1]) + (a[2] * a[2] + a[3] * a[3])) + ((b[0] * b[0] + b[1] * b[1]) + (b[2] * b[2] + b[3] * b[3])); }
__device__ __forceinline__ float row4_sum(float s) {
    s += __int_as_float(__builtin_amdgcn_ds_swizzle(__float_as_int(s), (16 << 10) | 0x1f));
    auto rr = __builtin_amdgcn_permlane32_swap(__float_as_uint(s), __float_as_uint(s), false, false); return __uint_as_float(rr[0]) + __uint_as_float(rr[1]); }
__device__ __forceinline__ float rstd_from_ss(float ss, float inv_n) { return __builtin_amdgcn_rsqf(ss * inv_n + 1e-6f); }
__device__ __forceinline__ void atomic_add_row(PG8_GAS float* p, float v) { asm volatile("global_atomic_add_f32 %0, %1, off sc1" :: "v"(p), "v"(v) : "memory"); }
struct EpiSwiGLU {
    static constexpr bool PERM = true, AFTER_DRAIN = false, ROWSCALE = true; static constexpr float INV_N = 1.f / 4096;
    PG8_GAS bf16_t* H; int ldh; const PG8_GAS float* SX;
    __device__ __forceinline__ void operator()(const f32x4 (&acc)[2][2][4][2], const Unit& u, int wr, int wc, int fr, int fq, const PG8_LAS float* rsl) const {
        const int row0 = u.pm * BM + wr * 64 + fr, col0 = u.pn * HALF + wc * 32 + 8 * fq;
#pragma unroll
        for (int ai = 0; ai < 2; ++ai)
#pragma unroll
            for (int m = 0; m < 4; ++m) { const int row = row0 + ai * HALF + m * 16; const float r = rsl[ai * 64 + m * 16 + fr];
                PG8_GAS bf16_t* rowp = H + (size_t)row * ldh + col0;
                const f32x4 g0 = acc[ai][0][m][0] * r, g1 = acc[ai][0][m][1] * r, u0 = acc[ai][1][m][0] * r, u1 = acc[ai][1][m][1] * r;
                const f32x4 v0 = (f32x4){silu_f(g0[0]) * u0[0], silu_f(g0[1]) * u0[1], silu_f(g0[2]) * u0[2], silu_f(g0[3]) * u0[3]};
                const f32x4 v1 = (f32x4){silu_f(g1[0]) * u1[0], silu_f(g1[1]) * u1[1], silu_f(g1[2]) * u1[2], silu_f(g1[3]) * u1[3]};
                *(PG8_GAS u32x4*)rowp = pack8(v0, v1);
            }
    }
};
struct EpiZ {
    static constexpr bool PERM = true, AFTER_DRAIN = false, ROWSCALE = true; static constexpr float INV_N = 1.f / 4096;
    PG8_GAS bf16_t *GU, *GV, *QL, *KVL, *KR, *GA, *GB; const PG8_GAS float* cs; const PG8_GAS float* sn; int smask; PG8_GAS float* SS; const PG8_GAS float* SX;
    __device__ __forceinline__ void operator()(const f32x4 (&acc)[2][2][4][2], const Unit& u, int wr, int wc, int fr, int fq, const PG8_LAS float* rsl) const {
        const int pn = u.pn, row0 = u.pm * BM + wr * 64 + fr, cw = wc * 32 + 8 * fq;
        if (pn < 16) {
            PG8_GAS bf16_t* dst = (pn < 8 ? GU : GV) + (pn & 7) * BM + cw;
#pragma unroll
            for (int ai = 0; ai < 2; ++ai)
#pragma unroll
                for (int m = 0; m < 4; ++m) { const int row = row0 + ai * HALF + m * 16; PG8_GAS bf16_t* rowp = dst + (size_t)row * 2048; float s = 0.f; const float r = rsl[ai * 64 + m * 16 + fr];
#pragma unroll
                    for (int bj = 0; bj < 2; ++bj) { const f32x4 t0 = gelu4(acc[ai][bj][m][0] * r), t1 = gelu4(acc[ai][bj][m][1] * r); s += ssq44(t0, t1); *(PG8_GAS u32x4*)(rowp + bj * HALF) = pack8(t0, t1); }
                    if (pn >= 8) { s = row4_sum(s); if (fq == 0) atomic_add_row(SS + row, s); } }
        } else if (pn < 22) {
            const bool isq = pn < 20; PG8_GAS bf16_t* dst = isq ? QL + (pn - 16) * BM + cw : KVL + (pn - 20) * BM + cw; const int ld = isq ? 1024 : 512;
#pragma unroll
            for (int ai = 0; ai < 2; ++ai)
#pragma unroll
                for (int m = 0; m < 4; ++m) { const int row = row0 + ai * HALF + m * 16; PG8_GAS bf16_t* rowp = dst + (size_t)row * ld; float s = 0.f; const float r = rsl[ai * 64 + m * 16 + fr];
#pragma unroll
                    for (int bj = 0; bj < 2; ++bj) { const f32x4 t0 = acc[ai][bj][m][0] * r, t1 = acc[ai][bj][m][1] * r; s += ssq44(t0, t1); *(PG8_GAS u32x4*)(rowp + bj * HALF) = pack8(t0, t1); }
                    s = row4_sum(s); if (fq == 0) atomic_add_row(SS + (isq ? 16384 : 32768) + row, s); }
        } else if (pn == 22) {
            if (wc == 0) {
#pragma unroll
                for (int ai = 0; ai < 2; ++ai)
#pragma unroll
                    for (int m = 0; m < 4; ++m) { const int row = row0 + ai * HALF + m * 16, s = row & smask;
                        const f32x4 c0 = *(const PG8_GAS f32x4*)(cs + (size_t)s * 32 + 8 * fq), c1 = *(const PG8_GAS f32x4*)(cs + (size_t)s * 32 + 8 * fq + 4);
                        const f32x4 s0 = *(const PG8_GAS f32x4*)(sn + (size_t)s * 32 + 8 * fq), s1 = *(const PG8_GAS f32x4*)(sn + (size_t)s * 32 + 8 * fq + 4);
                        const float r = rsl[ai * 64 + m * 16 + fr];
                        const f32x4 xa = acc[ai][0][m][0] * r, xb = acc[ai][0][m][1] * r, ya = acc[ai][1][m][0] * r, yb = acc[ai][1][m][1] * r;
                        PG8_GAS bf16_t* rowp = KR + (size_t)row * 64 + 8 * fq;
                        *(PG8_GAS u32x4*)rowp = pack8(xa * c0 - ya * s0, xb * c1 - yb * s1);
                        *(PG8_GAS u32x4*)(rowp + 32) = pack8(xa * s0 + ya * c0, xb * s1 + yb * c1); }
            }
        } else {
            const int t = pn - 23; PG8_GAS bf16_t* dst = (t < 16 ? GA : GB) + (t & 15) * BM + cw;
#pragma unroll
            for (int ai = 0; ai < 2; ++ai)
#pragma unroll
                for (int m = 0; m < 4; ++m) { const int row = row0 + ai * HALF + m * 16; PG8_GAS bf16_t* rowp = dst + (size_t)row * 4096; const float r = rsl[ai * 64 + m * 16 + fr];
#pragma unroll
                    for (int bj = 0; bj < 2; ++bj) *(PG8_GAS u32x4*)(rowp + bj * HALF) = pack8(sigmoid4(acc[ai][bj][m][0] * r), sigmoid4(acc[ai][bj][m][1] * r)); }
        }
    }
};
struct EpiQ {
    static constexpr bool PERM = true, AFTER_DRAIN = false, ROWSCALE = true; static constexpr float INV_N = 1.f / 1024;
    PG8_GAS bf16_t* Q; const PG8_GAS float* SX; const PG8_GAS float* cs; const PG8_GAS float* sn; int smask;
    __device__ __forceinline__ void operator()(const f32x4 (&acc)[2][2][4][2], const Unit& u, int wr, int wc, int fr, int fq, const PG8_LAS float* rsl) const {
        const int pn = u.pn, row0 = u.pm * BM + wr * 64 + fr;
        if (pn < 8) {
#pragma unroll
            for (int ai = 0; ai < 2; ++ai)
#pragma unroll
                for (int m = 0; m < 4; ++m) { const int row = row0 + ai * HALF + m * 16; const float r = rsl[ai * 64 + m * 16 + fr];
#pragma unroll
                    for (int bj = 0; bj < 2; ++bj) *(PG8_GAS u32x4*)(Q + (size_t)row * 3072 + (2 * pn + bj) * 192 + wc * 32 + 8 * fq) = pack8(acc[ai][bj][m][0] * r, acc[ai][bj][m][1] * r); }
        } else {
            const int head = 4 * (pn - 8) + wc;
#pragma unroll
            for (int ai = 0; ai < 2; ++ai)
#pragma unroll
                for (int m = 0; m < 4; ++m) { const int row = row0 + ai * HALF + m * 16, s = row & smask; const float r = rsl[ai * 64 + m * 16 + fr];
                    const f32x4 c0 = *(const PG8_GAS f32x4*)(cs + (size_t)s * 32 + 8 * fq), c1 = *(const PG8_GAS f32x4*)(cs + (size_t)s * 32 + 8 * fq + 4);
                    const f32x4 s0 = *(const PG8_GAS f32x4*)(sn + (size_t)s * 32 + 8 * fq), s1 = *(const PG8_GAS f32x4*)(sn + (size_t)s * 32 + 8 * fq + 4);
                    const f32x4 xa = acc[ai][0][m][0] * r, xb = acc[ai][0][m][1] * r, ya = acc[ai][1][m][0] * r, yb = acc[ai][1][m][1] * r;
                    PG8_GAS bf16_t* rowp = Q + (size_t)row * 3072 + head * 192 + 128 + 8 * fq;
                    *(PG8_GAS u32x4*)rowp = pack8(xa * c0 - ya * s0, xb * c1 - yb * s1);
                    *(PG8_GAS u32x4*)(rowp + 32) = pack8(xa * s0 + ya * c0, xb * s1 + yb * c1); }
        }
    }
};
struct EpiKV {
    static constexpr bool PERM = true, AFTER_DRAIN = false, ROWSCALE = true; static constexpr float INV_N = 1.f / 512;
    PG8_GAS bf16_t *KN, *V; const PG8_GAS float* SX;
    __device__ __forceinline__ void operator()(const f32x4 (&acc)[2][2][4][2], const Unit& u, int wr, int wc, int fr, int fq, const PG8_LAS float* rsl) const {
        const int row0 = u.pm * BM + wr * 64 + fr, col0 = u.pn * HALF + wc * 32 + 8 * fq;
#pragma unroll
        for (int ai = 0; ai < 2; ++ai)
#pragma unroll
            for (int m = 0; m < 4; ++m) { const int row = row0 + ai * HALF + m * 16; const float r = rsl[ai * 64 + m * 16 + fr];
                *(PG8_GAS u32x4*)(KN + (size_t)row * 2048 + col0) = pack8(acc[ai][0][m][0] * r, acc[ai][0][m][1] * r);
                *(PG8_GAS u32x4*)(V + (size_t)row * 2048 + col0) = pack8(acc[ai][1][m][0] * r, acc[ai][1][m][1] * r); }
    }
};
template <int MODE> struct EpiGate {
    static constexpr bool PERM = true, AFTER_DRAIN = false, ROWSCALE = false;
    PG8_GAS bf16_t* O; const PG8_GAS bf16_t* G; const PG8_GAS bf16_t* P; int ldc;
    __device__ __forceinline__ void operator()(const f32x4 (&acc)[2][2][4][2], const Unit& u, int wr, int wc, int fr, int fq) const {
        const int row0 = u.pm * BM + wr * 64 + fr, col0 = u.pn * BM + wc * 32 + 8 * fq;
#pragma unroll
        for (int ai = 0; ai < 2; ++ai) {
            u32x4 gin[4][2], pin[4][2];
            if (MODE >= 1) {
#pragma unroll
                for (int m = 0; m < 4; ++m)
#pragma unroll
                    for (int bj = 0; bj < 2; ++bj) { const size_t off = (size_t)(row0 + ai * HALF + m * 16) * ldc + col0 + bj * HALF;
                        gin[m][bj] = *(const PG8_GAS u32x4*)(G + off); if (MODE == 2) pin[m][bj] = *(const PG8_GAS u32x4*)(P + off); }
            }
#pragma unroll
            for (int m = 0; m < 4; ++m)
#pragma unroll
                for (int bj = 0; bj < 2; ++bj) { const size_t off = (size_t)(row0 + ai * HALF + m * 16) * ldc + col0 + bj * HALF; f32x4 v0 = acc[ai][bj][m][0], v1 = acc[ai][bj][m][1];
                    if (MODE >= 1) { f32x4 g0, g1; unpack8(gin[m][bj], g0, g1); v0 = v0 * g0; v1 = v1 * g1; }
                    if (MODE == 2) { f32x4 p0, p1; unpack8(pin[m][bj], p0, p1); v0 = v0 + p0; v1 = v1 + p1; }
                    *(PG8_GAS u32x4*)(O + off) = pack8(v0, v1); }
        }
    }
};
template <bool HALF_ALPHA> struct EpiResid {
    static constexpr bool PERM = true, AFTER_DRAIN = false, ROWSCALE = false;
    PG8_GAS bf16_t* X; PG8_GAS float* SX;
    __device__ __forceinline__ void operator()(const f32x4 (&acc)[2][2][4][2], const Unit& u, int wr, int wc, int fr, int fq) const {
        const int row0 = u.pm * BM + wr * 64 + fr, col0 = u.pn * BM + wc * 32 + 8 * fq; const float alpha = HALF_ALPHA ? 0.5f : 1.0f;
        u32x4 xin[2][4][2];
#pragma unroll
        for (int ai = 0; ai < 2; ++ai)
#pragma unroll
            for (int m = 0; m < 4; ++m)
#pragma unroll
                for (int bj = 0; bj < 2; ++bj) xin[ai][m][bj] = *(const PG8_GAS u32x4*)(X + (size_t)(row0 + ai * HALF + m * 16) * 4096 + col0 + bj * HALF);
#pragma unroll
        for (int ai = 0; ai < 2; ++ai)
#pragma unroll
            for (int m = 0; m < 4; ++m) { const int row = row0 + ai * HALF + m * 16; const size_t off = (size_t)row * 4096 + col0; float s = 0.f;
#pragma unroll
                for (int bj = 0; bj < 2; ++bj) { f32x4 x0, x1; unpack8(xin[ai][m][bj], x0, x1);
                    const f32x4 v0 = x0 + acc[ai][bj][m][0] * alpha, v1 = x1 + acc[ai][bj][m][1] * alpha; s += ssq44(v0, v1);
                    *(PG8_GAS u32x4*)(X + off + bj * HALF) = pack8(v0, v1); }
                s = row4_sum(s); if (fq == 0) atomic_add_row(SX + row, s); }
    }
};
struct EpiPleGate {
    static constexpr bool PERM = true, AFTER_DRAIN = false, ROWSCALE = true; static constexpr float INV_N = 1.f / 4096;
    PG8_GAS bf16_t* TT; const PG8_GAS bf16_t* PP; int ldc; PG8_GAS float* sst; const PG8_GAS float* SX;
    __device__ __forceinline__ void operator()(const f32x4 (&acc)[2][2][4][2], const Unit& u, int wr, int wc, int fr, int fq, const PG8_LAS float* rsl) const {
        const int row0 = u.pm * BM + wr * 64 + fr, col0 = u.pn * BM + wc * 32 + 8 * fq;
        u32x4 pin[2][4][2];
#pragma unroll
        for (int ai = 0; ai < 2; ++ai)
#pragma unroll
            for (int m = 0; m < 4; ++m)
#pragma unroll
                for (int bj = 0; bj < 2; ++bj) pin[ai][m][bj] = *(const PG8_GAS u32x4*)(PP + (size_t)(row0 + ai * HALF + m * 16) * ldc + col0 + bj * HALF);
#pragma unroll
        for (int ai = 0; ai < 2; ++ai)
#pragma unroll
            for (int m = 0; m < 4; ++m) { const int row = row0 + ai * HALF + m * 16; const size_t off = (size_t)row * ldc + col0; float s = 0.f; const float r = rsl[ai * 64 + m * 16 + fr];
#pragma unroll
                for (int bj = 0; bj < 2; ++bj) { f32x4 p0, p1; unpack8(pin[ai][m][bj], p0, p1);
                    const f32x4 t0 = sigmoid4(acc[ai][bj][m][0] * r) * p0, t1 = sigmoid4(acc[ai][bj][m][1] * r) * p1;
                    s += ssq44(t0, t1);
                    *(PG8_GAS u32x4*)(TT + off + bj * HALF) = pack8(t0, t1); }
                s = row4_sum(s); if (fq == 0) atomic_add_row(sst + row, s); }
    }
};

template <class Epi, class Sched, bool ALIGN_EPI = false, bool SP2 = false>
__device__ __forceinline__ void gemm_phase(PG8_LAS unsigned char* lds, const Gemm g, const Sched& S, const Epi& E, const int tid) {
    const int wid = __builtin_amdgcn_readfirstlane(tid >> 6), lane = tid & 63, wr = wid >> 2, wc = wid & 3, fr = lane & 15, fq = lane >> 4;
    const int K = g.K, nt = K / BK;
    unsigned voffA[2], voffB[2];
#pragma unroll
    for (int i = 0; i < 2; ++i) { int R, C; stage_rc(tid * 16 + i * 8192, R, C); const int Rb = Epi::PERM ? ((R & ~31) + perm32(R & 31)) : R;
        voffA[i] = (unsigned)(R * K + C) * 2u; voffB[i] = (unsigned)(Rb * K + C) * 2u; }
    const size_t kstep = (size_t)(BK * 2);
    const size_t hstep = (size_t)HALF * K * 2;
    const size_t tstep = 2 * hstep;
    const unsigned ldsw = (unsigned)wid * 1024u;
    const int aoff = lds_byte(wr * 64 + fr, fq * 8), boff = lds_byte(wc * 32 + fr, fq * 8);
#define PG8_SA(b, h) (((b) * 2 + (h)) * HTB)
#define PG8_SB(b, h) ((4 + (b) * 2 + (h)) * HTB)
#define PG8_STAGE(bufoff, gbase, voff) do { _Pragma("unroll") for (int _i = 0; _i < 2; ++_i) \
        __builtin_amdgcn_global_load_lds((const PG8_GAS unsigned*)((const PG8_GAS char*)(gbase) + (voff)[_i]), (PG8_LAS unsigned*)(lds + (bufoff) + ldsw + _i * 8192), 16, 0, 0); } while (0)
#define PG8_LDA(dst, b, h) do { _Pragma("unroll") for (int m = 0; m < 4; ++m) _Pragma("unroll") for (int k = 0; k < 2; ++k) dst[m][k] = *(const PG8_LAS bf16x8*)(lds + PG8_SA(b, h) + aoff + m * 2048 + k * 1024); } while (0)
#define PG8_LDB(dst, b, h) do { _Pragma("unroll") for (int n = 0; n < 2; ++n) _Pragma("unroll") for (int k = 0; k < 2; ++k) dst[n][k] = *(const PG8_LAS bf16x8*)(lds + PG8_SB(b, h) + boff + n * 2048 + k * 1024); } while (0)
#define PG8_MMA(ai, bj, At, Bt) do { __builtin_amdgcn_s_setprio(1); _Pragma("unroll") for (int m = 0; m < 4; ++m) _Pragma("unroll") for (int n = 0; n < 2; ++n) _Pragma("unroll") for (int k = 0; k < 2; ++k) \
        acc[ai][bj][m][n] = __builtin_amdgcn_mfma_f32_16x16x32_bf16(Bt[n][k], At[m][k], acc[ai][bj][m][n], 0, 0, 0); __builtin_amdgcn_s_setprio(0); } while (0)
#define PG8_WAIT_V(n) asm volatile("s_waitcnt vmcnt(" #n ")" ::: "memory")
#define PG8_WAIT_L(n) asm volatile("s_waitcnt lgkmcnt(" #n ")" ::: "memory")
#define PG8_BAR __builtin_amdgcn_s_barrier()
#define PG8_SCHED __builtin_amdgcn_sched_barrier(0)
    Unit cur, nxt; int ui = 0; int rs_tag = -1;
    if (!S.next(0, cur)) return;
    f32x4 acc[2][2][4][2];
#pragma unroll
    for (int a = 0; a < 2; ++a)
#pragma unroll
        for (int b = 0; b < 2; ++b)
#pragma unroll
            for (int m = 0; m < 4; ++m)
#pragma unroll
                for (int n = 0; n < 2; ++n) acc[a][b][m][n] = (f32x4){0.f, 0.f, 0.f, 0.f};
    bf16x8 At[4][2], B0[2][2], B1[2][2];
    const PG8_GAS char* cA = (const PG8_GAS char*)g.A + (size_t)cur.pm * tstep; const PG8_GAS char* cB = (const PG8_GAS char*)g.Bt + (size_t)cur.pn * tstep;
    S.a_ready(cur);
    if constexpr (SP2) {
        PG8_STAGE(PG8_SB(0, 0), cB, voffB); PG8_STAGE(PG8_SB(0, 1), cB + hstep, voffB); PG8_STAGE(PG8_SA(0, 0), cA, voffA); PG8_STAGE(PG8_SA(0, 1), cA + hstep, voffA);
        if (wr == 1) PG8_BAR;
        PG8_WAIT_V(2); PG8_BAR;
        PG8_STAGE(PG8_SB(1, 0), cB + kstep, voffB); PG8_STAGE(PG8_SA(1, 0), cA + kstep, voffA); PG8_STAGE(PG8_SB(1, 1), cB + hstep + kstep, voffB);
        PG8_WAIT_V(6); PG8_BAR;
    } else {
        PG8_STAGE(PG8_SB(0, 0), cB, voffB); PG8_STAGE(PG8_SA(0, 0), cA, voffA); PG8_STAGE(PG8_SB(0, 1), cB + hstep, voffB); PG8_STAGE(PG8_SA(0, 1), cA + hstep, voffA);
        if (wr == 1) PG8_BAR;
        PG8_WAIT_V(4); PG8_BAR;
        PG8_STAGE(PG8_SB(1, 0), cB + kstep, voffB); PG8_STAGE(PG8_SA(1, 0), cA + kstep, voffA); PG8_STAGE(PG8_SB(1, 1), cB + hstep + kstep, voffB);
        PG8_WAIT_V(6); PG8_BAR;
    }
    for (;;) {
        const bool has_next = S.next(ui + 1, nxt);
        const PG8_GAS char* nA = has_next ? (const PG8_GAS char*)g.A + (size_t)nxt.pm * tstep : cA; const PG8_GAS char* nB = has_next ? (const PG8_GAS char*)g.Bt + (size_t)nxt.pn * tstep : cB;
        for (int t = 0; t < nt; t += 2) {
            const bool last = (t == nt - 2);
            const PG8_GAS char* a1 = cA + (size_t)(t + 1) * kstep;
            const PG8_GAS char* a2 = last ? nA : cA + (size_t)(t + 2) * kstep; const PG8_GAS char* b2 = last ? nB : cB + (size_t)(t + 2) * kstep;
            const PG8_GAS char* a3 = a2 + kstep; const PG8_GAS char* b3 = b2 + kstep;
            if (last && has_next) S.a_ready(nxt);
            if constexpr (SP2) {
            PG8_LDB(B0, 0, 0); PG8_LDB(B1, 0, 1); PG8_SCHED; PG8_LDA(At, 0, 0); PG8_STAGE(PG8_SA(1, 1), a1 + hstep, voffA);
            PG8_WAIT_V(8); PG8_WAIT_L(0); PG8_BAR; PG8_MMA(0, 0, At, B0); PG8_MMA(0, 1, At, B1); PG8_BAR; PG8_SCHED;
            PG8_LDA(At, 0, 1); PG8_STAGE(PG8_SB(0, 0), b2, voffB); PG8_STAGE(PG8_SB(0, 1), b2 + hstep, voffB); PG8_STAGE(PG8_SA(0, 0), a2, voffA);
            PG8_WAIT_V(8); PG8_WAIT_L(0); PG8_BAR; PG8_MMA(1, 0, At, B0); PG8_MMA(1, 1, At, B1); PG8_BAR; PG8_SCHED;
            PG8_LDB(B0, 1, 0); PG8_LDB(B1, 1, 1); PG8_SCHED; PG8_LDA(At, 1, 0); PG8_STAGE(PG8_SA(0, 1), a2 + hstep, voffA);
            PG8_WAIT_V(8); PG8_WAIT_L(0); PG8_BAR; PG8_MMA(0, 0, At, B0); PG8_MMA(0, 1, At, B1); PG8_BAR; PG8_SCHED;
            PG8_LDA(At, 1, 1); PG8_STAGE(PG8_SB(1, 0), b3, voffB); PG8_STAGE(PG8_SB(1, 1), b3 + hstep, voffB); PG8_STAGE(PG8_SA(1, 0), a3, voffA);
            PG8_WAIT_V(8); PG8_WAIT_L(0); PG8_BAR; PG8_MMA(1, 0, At, B0); PG8_MMA(1, 1, At, B1); PG8_BAR; PG8_SCHED;
            } else {
            PG8_LDB(B0, 0, 0); PG8_SCHED; PG8_LDA(At, 0, 0); PG8_STAGE(PG8_SA(1, 1), a1 + hstep, voffA);
            PG8_WAIT_L(8); PG8_BAR; PG8_WAIT_L(0); PG8_MMA(0, 0, At, B0); PG8_BAR; PG8_SCHED;
            PG8_LDB(B1, 0, 1); PG8_STAGE(PG8_SB(0, 0), b2, voffB);
            PG8_BAR; PG8_WAIT_L(0); PG8_MMA(0, 1, At, B1); PG8_BAR;
            PG8_LDA(At, 0, 1); PG8_STAGE(PG8_SA(0, 0), a2, voffA);
            PG8_BAR; PG8_WAIT_L(0); PG8_MMA(1, 0, At, B0); PG8_BAR; PG8_SCHED;
            PG8_STAGE(PG8_SB(0, 1), b2 + hstep, voffB);
            PG8_WAIT_V(6); PG8_BAR; PG8_MMA(1, 1, At, B1); PG8_BAR;
            PG8_LDB(B0, 1, 0); PG8_SCHED; PG8_LDA(At, 1, 0); PG8_STAGE(PG8_SA(0, 1), a2 + hstep, voffA);
            PG8_WAIT_L(8); PG8_BAR; PG8_WAIT_L(0); PG8_MMA(0, 0, At, B0); PG8_BAR; PG8_SCHED;
            PG8_LDB(B1, 1, 1); PG8_STAGE(PG8_SB(1, 0), b3, voffB);
            PG8_BAR; PG8_WAIT_L(0); PG8_MMA(0, 1, At, B1); PG8_BAR;
            PG8_LDA(At, 1, 1); PG8_STAGE(PG8_SA(1, 0), a3, voffA);
            PG8_BAR; PG8_WAIT_L(0); PG8_MMA(1, 0, At, B0); PG8_BAR; PG8_SCHED;
            PG8_STAGE(PG8_SB(1, 1), b3 + hstep, voffB);
            PG8_WAIT_V(6); PG8_BAR; PG8_MMA(1, 1, At, B1); PG8_BAR;
            }
        }
        if constexpr (ALIGN_EPI) { if (wr == 0) PG8_BAR; }
        if constexpr (!Epi::AFTER_DRAIN) {
            if constexpr (Epi::ROWSCALE) {
                PG8_LAS float* rsl = (PG8_LAS float*)(lds + RS_OFF + wid * 512);
                if (cur.pm != rs_tag) { rs_tag = cur.pm; const int rb = cur.pm * BM + wr * 64 + lane; rsl[lane] = rstd_from_ss(E.SX[rb], Epi::INV_N); rsl[64 + lane] = rstd_from_ss(E.SX[rb + HALF], Epi::INV_N); }
                E(acc, cur, wr, wc, fr, fq, rsl);
            } else E(acc, cur, wr, wc, fr, fq);
            S.done(cur); }
        if (!has_next) break;
#pragma unroll
        for (int a = 0; a < 2; ++a)
#pragma unroll
            for (int b = 0; b < 2; ++b)
#pragma unroll
                for (int m = 0; m < 4; ++m)
#pragma unroll
                    for (int n = 0; n < 2; ++n) acc[a][b][m][n] = (f32x4){0.f, 0.f, 0.f, 0.f};
        cur = nxt; cA = nA; cB = nB; ++ui;
        if constexpr (ALIGN_EPI) { if (wr == 1) PG8_BAR; }
    }
    PG8_WAIT_V(0);
    if constexpr (!ALIGN_EPI) { if (wr == 0) PG8_BAR; }
    PG8_BAR;
#undef PG8_SA
#undef PG8_SB
#undef PG8_STAGE
#undef PG8_LDA
#undef PG8_LDB
#undef PG8_MMA
#undef PG8_WAIT_V
#undef PG8_WAIT_L
#undef PG8_BAR
#undef PG8_SCHED
}
}

constexpr int NWAVES = 8;
constexpr int D = 4096, DFF = 11008, MROWS = 16384, NGRP = 2, PLE = 256, GMW = 2048, NH = 16, QLR = 1024, KVR = 512;
constexpr int INW = 13888, INWP = 14080, QW = 3072, KVW = 4096;
constexpr float EPS = 1e-6f;
constexpr size_t MiB = 1u << 20;
constexpr size_t WS_CTL = 0, CTL_ZERO_BYTES = 1152 * 1024;
constexpr size_t WS_COS = 2 * MiB, WS_SIN = 3 * MiB, WS_SS = 256 * 1024;
constexpr size_t WS_WF1U = 8 * MiB, WS_WF1D = WS_WF1U + 172 * MiB, WS_WF2U = WS_WF1D + 86 * MiB, WS_WF2D = WS_WF2U + 172 * MiB;
constexpr size_t WS_WIN = WS_WF2D + 86 * MiB, WS_WOA = WS_WIN + 110 * MiB, WS_WOB = WS_WOA + 16 * MiB, WS_WUQ = WS_WOB + 16 * MiB, WS_WUKV = WS_WUQ + 6 * MiB;
constexpr size_t WS_WO = WS_WUKV + 4 * MiB, WS_WPG = WS_WO + 32 * MiB, WS_WPP = WS_WPG + 32 * MiB, WS_WEND = WS_WPP + 2 * MiB;
static_assert(WS_WEND == 742 * MiB, "weight map");
constexpr size_t WS_XN = 744 * MiB;
constexpr size_t WS_R1 = WS_XN + 256 * MiB;
constexpr size_t WS_H = WS_R1, WS_GU = WS_R1, WS_GV = WS_R1 + 64 * MiB, WS_QL = WS_R1 + 128 * MiB, WS_KVL = WS_R1 + 160 * MiB, WS_KR = WS_R1 + 176 * MiB;
constexpr size_t WS_GA = WS_R1 + 192 * MiB, WS_GB = WS_R1 + 320 * MiB, WS_PP = WS_R1, WS_TT = WS_R1 + 256 * MiB;
constexpr size_t WS_Q = WS_R1 + 448 * MiB, WS_KN = WS_Q + 96 * MiB, WS_M1 = WS_GU, WS_MG = WS_KN, WS_V = WS_KN + 64 * MiB, WS_AO = WS_V + 64 * MiB, WS_GM = WS_AO + 64 * MiB;
constexpr size_t WS_PB = WS_R1 + 800 * MiB;
constexpr size_t WS_END = WS_PB + 16 * MiB;
static_assert((size_t)2 * MROWS * DFF * 2 <= 800 * MiB && WS_GM + 64 * MiB == WS_R1 + 800 * MiB && WS_END == 1816 * MiB, "activation map");
constexpr int CW_BAR = 4096, CW_XRANK = 12288;
constexpr size_t WS_SX = 640 * 1024;
constexpr size_t WS_SST = 65536;
constexpr int RING_OFF = 0, RING_BYTES = 131072;
constexpr int LDSCTL_OFF = RING_BYTES, MISC_OFF = LDSCTL_OFF + 320;
constexpr int LDS_BYTES = 147456;

#define GAS __attribute__((address_space(1)))
#define LAS __attribute__((address_space(3)))
typedef unsigned short bf16;
typedef unsigned v4u __attribute__((ext_vector_type(4)));
typedef unsigned v2u __attribute__((ext_vector_type(2)));
typedef float f32x4 __attribute__((ext_vector_type(4)));
typedef float f32x16 __attribute__((ext_vector_type(16)));
typedef short bf16x8 __attribute__((ext_vector_type(8)));
typedef short s16x4 __attribute__((ext_vector_type(4)));
typedef GAS unsigned gu32;
#define RLX_AGENT __ATOMIC_RELAXED, __HIP_MEMORY_SCOPE_AGENT
#define LDS_WAIT() asm volatile("s_waitcnt lgkmcnt(0)" ::: "memory")
#define VM_WAIT() asm volatile("s_waitcnt vmcnt(0)" ::: "memory")
__device__ __forceinline__ unsigned f2bf(float f) { unsigned u = __builtin_bit_cast(unsigned, f); return (u + 0x7fffu + ((u >> 16) & 1u)) >> 16; }
__device__ __forceinline__ unsigned pk2(float lo, float hi) { return f2bf(lo) | (f2bf(hi) << 16); }

#define XB_TMO      128
#define XB_XCNT(j)  (256  + 64 * (j))
#define XB_XSUB(j)  (1280 + 64 * (j))
#define XB_XGEN(j)  (2304 + 64 * (j))
#define XB_TOP      3328
#define XB_TOPGEN   3392
#define XCD_BAR_WORDS 3456
#define XB_SPIN_CAP (1u << 20)
__device__ __forceinline__ unsigned xb_ld(unsigned* p)              { return __hip_atomic_load(p, __ATOMIC_RELAXED, __HIP_MEMORY_SCOPE_AGENT); }
__device__ __forceinline__ unsigned xb_add(unsigned* p, unsigned v) { return __hip_atomic_fetch_add(p, v, __ATOMIC_RELAXED, __HIP_MEMORY_SCOPE_AGENT); }
__device__ __forceinline__ unsigned xb_xcc_id() { return (unsigned)__builtin_amdgcn_s_getreg((3 << 11) | 20) & 0xFu; }
#define XB_SPIN(cond, bar) do { unsigned _sp = 0; while (cond) { __builtin_amdgcn_s_sleep(1); \
    if ((++_sp & 255u) == 0u) { if (xb_ld(&(bar)[XB_TMO])) break; if (_sp > XB_SPIN_CAP) { atomicAdd(&(bar)[XB_TMO], 1u); break; } } } } while (0)
struct XcdBarrier { unsigned* bar; unsigned x; volatile LAS unsigned* st; bool leader; };
__device__ __forceinline__ XcdBarrier xcd_barrier_post(unsigned* bar, volatile LAS unsigned* st, bool leader) {
    XcdBarrier b; b.bar = bar; b.x = xb_xcc_id(); b.st = st; b.leader = leader;
    if (leader) (void)xb_add(&bar[XB_XCNT(b.x)], 1u);
    return b;
}
__device__ __forceinline__ void xcd_barrier_complete(unsigned* bar, unsigned x, unsigned& nloc, unsigned& nx) {
    const unsigned G = gridDim.x * gridDim.y * gridDim.z;
    unsigned sum, cnt, mine, sp = 0u;
    for (;;) {
        sum = 0u; cnt = 0u; mine = 0u;
#pragma unroll
        for (unsigned j = 0; j < 16; ++j) { const unsigned c = xb_ld(&bar[XB_XCNT(j)]); sum += c; cnt += (c > 0u) ? 1u : 0u; mine = (j == x) ? c : mine; }
        if (sum == G) break;
        __builtin_amdgcn_s_sleep(1);
        if ((++sp & 255u) == 0u) { if (xb_ld(&bar[XB_TMO])) break; if (sp > XB_SPIN_CAP) { atomicAdd(&bar[XB_TMO], 1u); break; } }
    }
    nloc = mine > 0u ? mine : 1u; nx = cnt > 0u ? cnt : 1u;
}
__device__ __forceinline__ void xcd_barrier(const XcdBarrier& b) {
    asm volatile("s_waitcnt vmcnt(0)" ::: "memory");
    __syncthreads();
    if (b.leader) {
        unsigned* bar = b.bar;
        __builtin_amdgcn_s_waitcnt(0);
        unsigned nloc = b.st[0], nx = b.st[1];
        if (nloc == 0u) { xcd_barrier_complete(bar, b.x, nloc, nx); b.st[0] = nloc; b.st[1] = nx; }
        const unsigned old = xb_add(&bar[XB_XSUB(b.x)], 1u);
        const unsigned gen = old / nloc;
        if (old + 1u == (gen + 1u) * nloc) {
            __builtin_amdgcn_fence(__ATOMIC_RELEASE, "agent");
            asm volatile("s_waitcnt vmcnt(0)" ::: "memory");
            const unsigned og = xb_add(&bar[XB_TOP], 1u);
            const unsigned tg = og / nx;
            if (og + 1u == (tg + 1u) * nx) xb_add(&bar[XB_TOPGEN], 1u);
            else XB_SPIN(xb_ld(&bar[XB_TOPGEN]) == tg, bar);
            __builtin_amdgcn_fence(__ATOMIC_ACQUIRE, "agent");
            xb_add(&bar[XB_XGEN(b.x)], 1u);
            asm volatile("s_waitcnt vmcnt(0)" ::: "memory");
        } else {
            XB_SPIN(xb_ld(&bar[XB_XGEN(b.x)]) == gen, bar);
            __builtin_amdgcn_fence(__ATOMIC_ACQUIRE, "agent");
            asm volatile("s_waitcnt vmcnt(0)" ::: "memory");
        }
    }
    __syncthreads();
}

struct Args { const float* in[29]; float* out; unsigned char* ws; };
typedef GAS float gf32; typedef GAS unsigned short gbf16;
struct Frame {
    LAS unsigned char* lds;
    int tid, lane, wave, G, bid, gw, ngw;
    int xc, wx;
};
__device__ __forceinline__ float wave_sum(float v) {
    v += __int_as_float(__builtin_amdgcn_ds_swizzle(__float_as_int(v), (1 << 10) | 0x1f));
    v += __int_as_float(__builtin_amdgcn_ds_swizzle(__float_as_int(v), (2 << 10) | 0x1f));
    v += __int_as_float(__builtin_amdgcn_ds_swizzle(__float_as_int(v), (4 << 10) | 0x1f));
    v += __int_as_float(__builtin_amdgcn_ds_swizzle(__float_as_int(v), (8 << 10) | 0x1f));
    v += __int_as_float(__builtin_amdgcn_ds_swizzle(__float_as_int(v), (16 << 10) | 0x1f));
    auto rr = __builtin_amdgcn_permlane32_swap(__float_as_uint(v), __float_as_uint(v), false, false);
    return __uint_as_float(rr[0]) + __uint_as_float(rr[1]);
}

__device__ __forceinline__ void tr_item(const gf32* W, int ldw, int k0, int n0src, gbf16* WT, int K, int row0dst, const gf32* kscale, LAS float* scr, int lane) {
    f32x4 wv[8];
#pragma unroll
    for (int i = 0; i < 8; ++i) wv[i] = __builtin_nontemporal_load((const GAS f32x4*)(W + (size_t)(k0 + 8 * i + (lane >> 3)) * ldw + n0src + (lane & 7) * 4));
#pragma unroll
    for (int i = 0; i < 8; ++i) { LAS float* d = scr + (8 * i + (lane >> 3)) * 33 + (lane & 7) * 4; d[0] = wv[i].x; d[1] = wv[i].y; d[2] = wv[i].z; d[3] = wv[i].w; }
    LDS_WAIT(); asm volatile("" ::: "memory");
    const int c = lane & 7;
    f32x4 ka = (f32x4){1.f, 1.f, 1.f, 1.f}, kb = ka;
    if (kscale) { ka = *(const GAS f32x4*)(kscale + k0 + 8 * c); kb = *(const GAS f32x4*)(kscale + k0 + 8 * c + 4); }
#pragma unroll
    for (int j = 0; j < 4; ++j) { const int n = (lane >> 3) + 8 * j; const LAS float* s = scr + (8 * c) * 33 + n;
        v4u o; o.x = pk2(s[0 * 33] * ka.x, s[1 * 33] * ka.y); o.y = pk2(s[2 * 33] * ka.z, s[3 * 33] * ka.w); o.z = pk2(s[4 * 33] * kb.x, s[5 * 33] * kb.y); o.w = pk2(s[6 * 33] * kb.z, s[7 * 33] * kb.w);
        *(GAS v4u*)(WT + (size_t)(row0dst + n) * K + k0 + 8 * c) = o; }
    LDS_WAIT(); asm volatile("" ::: "memory");
}
template <int MAP> __device__ __forceinline__ void tr_matrix(const Frame& F, const gf32* W, const gf32* W2, int ldw, int K, int NP, gbf16* WT, const gf32* kscale, LAS float* scr, int& base) {
    const int nkb = K / 64, nnb = NP / 32, nitems = nkb * nnb;
    int it = ((F.gw - base) % F.ngw + F.ngw) % F.ngw;
    for (; it < nitems; it += F.ngw) {
        const int nb = it / nkb, kb = it % nkb, n0 = nb * 32; const gf32* src = W; int c0 = n0;
        if (MAP == 1) { const int t = n0 >> 8, r = n0 & 255; src = (r >= 128) ? W2 : W; c0 = 128 * t + (r & 127); }
        if (MAP == 2) { const int t = n0 >> 8, r = n0 & 255; if (t < 22) c0 = n0; else if (t == 22) c0 = (r == 128) ? 5664 : 5632; else c0 = 5696 + (n0 - 23 * 256); }
        if (MAP == 3) { if (n0 < 2048) { const int t = n0 >> 8, bj = (n0 >> 7) & 1, jj = n0 & 127; c0 = (2 * t + bj) * 192 + jj; }
                        else { const int r = n0 - 2048, t = r >> 8, bj = (r >> 7) & 1, hh = (r >> 5) & 3; c0 = (4 * t + hh) * 192 + 128 + 32 * bj; } }
        tr_item(src, ldw, kb * 64, c0, WT, K, n0, kscale, scr, F.lane);
    }
    base = (base + nitems) % F.ngw;
}

__device__ __forceinline__ void row_to_bf16_ss(const gf32* xrow, gbf16* orow, gf32* ss, int lane) {
    const GAS f32x4* xr = (const GAS f32x4*)xrow + lane; GAS v2u* o8 = (GAS v2u*)orow + lane; float s = 0.f;
#pragma unroll
    for (int j = 0; j < 16; ++j) { const f32x4 v = __builtin_nontemporal_load(xr + 64 * j); s += (v.x * v.x + v.y * v.y) + (v.z * v.z + v.w * v.w); v2u w; w.x = pk2(v.x, v.y); w.y = pk2(v.z, v.w); o8[64 * j] = w; }
    s = wave_sum(s); if (lane == 0) *ss = s;
}
__device__ __forceinline__ float ssq8(const v4u w) {
    const float a = pg8::bf_lo(w.x), b = pg8::bf_hi(w.x), c = pg8::bf_lo(w.y), d = pg8::bf_hi(w.y), e = pg8::bf_lo(w.z), f = pg8::bf_hi(w.z), g = pg8::bf_lo(w.w), h = pg8::bf_hi(w.w);
    return ((a * a + b * b) + (c * c + d * d)) + ((e * e + f * f) + (g * g + h * h));
}

__device__ __forceinline__ void gmlp_phase(const Frame& F, const gf32* ws, const gf32* bs, const gf32* gvn, const gbf16* GU, const gbf16* GV, const gf32* RSV, gbf16* GM) {
    LAS unsigned char* As = F.lds;
    LAS unsigned char* Bs = F.lds + 34816;
    LAS float* rsl = (LAS float*)(F.lds + 69632);
    const int tid = F.tid, lane = F.lane, w = F.wave, fr = lane & 15, fq = lane >> 4;
    const int nitems = (MROWS / 128) * 16;
    (void)nitems;
    for (int k_ = 0; k_ < 8; ++k_) { const int ii = (F.bid >> 3) + 32 * k_;
        const int ch = 16 * F.xc + (ii >> 4), gg = ii & 15, row0 = ch * 128;
        if (tid < 128) rsl[tid] = pg8::rstd_from_ss(RSV[row0 + tid], 1.f / GMW);
        __syncthreads();
#pragma unroll
        for (int i = 0; i < 4; ++i) { const int c = tid + 512 * i, p = c >> 4, q8 = c & 15;
            const f32x4 w0 = *(const GAS f32x4*)(ws + ((size_t)(gg * 128 + p)) * 128 + q8 * 8), w1 = *(const GAS f32x4*)(ws + ((size_t)(gg * 128 + p)) * 128 + q8 * 8 + 4);
            const f32x4 r0 = *(const LAS f32x4*)(rsl + q8 * 8), r1 = *(const LAS f32x4*)(rsl + q8 * 8 + 4);
            *(LAS v4u*)(As + p * 272 + q8 * 16) = pg8::pack8(w0 * r0, w1 * r1); }
#pragma unroll
        for (int i = 0; i < 4; ++i) { const int c = tid + 512 * i, q = c >> 4, c8 = c & 15;
            const v4u v = *(const GAS v4u*)(GV + (size_t)(row0 + q) * GMW + gg * 128 + c8 * 8);
            const int qq = (q ^ (c8 << 3)) * 2; LAS unsigned char* bp = Bs + (c8 * 8) * 272 + qq;
            *(LAS unsigned short*)(bp + 0 * 272) = (unsigned short)(v.x & 0xffffu); *(LAS unsigned short*)(bp + 1 * 272) = (unsigned short)(v.x >> 16);
            *(LAS unsigned short*)(bp + 2 * 272) = (unsigned short)(v.y & 0xffffu); *(LAS unsigned short*)(bp + 3 * 272) = (unsigned short)(v.y >> 16);
            *(LAS unsigned short*)(bp + 4 * 272) = (unsigned short)(v.z & 0xffffu); *(LAS unsigned short*)(bp + 5 * 272) = (unsigned short)(v.z >> 16);
            *(LAS unsigned short*)(bp + 6 * 272) = (unsigned short)(v.w & 0xffffu); *(LAS unsigned short*)(bp + 7 * 272) = (unsigned short)(v.w >> 16); }
        __syncthreads();
        f32x4 acc[8];
#pragma unroll
        for (int ni = 0; ni < 8; ++ni) acc[ni] = (f32x4){0.f, 0.f, 0.f, 0.f};
#pragma unroll
        for (int kb = 0; kb < 4; ++kb) {
            const bf16x8 a = *(const LAS bf16x8*)(As + (16 * w + fr) * 272 + (kb * 32 + fq * 8) * 2);
#pragma unroll
            for (int ni = 0; ni < 8; ++ni) { const int cc = 16 * ni + fr, c8 = cc >> 3;
                const bf16x8 b = *(const LAS bf16x8*)(Bs + cc * 272 + (((kb * 32 + fq * 8) ^ (c8 << 3)) * 2));
                acc[ni] = __builtin_amdgcn_mfma_f32_16x16x32_bf16(b, a, acc[ni], 0, 0, 0); }
        }
        const int row = row0 + 16 * w + fr; const float bsv = bs[gg * 128 + 16 * w + fr];
#pragma unroll
        for (int ni = 0; ni < 8; ++ni) { const int c0 = gg * 128 + 16 * ni + 4 * fq;
            const v2u gu = *(const GAS v2u*)(GU + (size_t)row * GMW + c0); const f32x4 gn = *(const GAS f32x4*)(gvn + c0);
            const float o0 = pg8::bf_lo(gu.x) * (gn[0] * acc[ni][0] + bsv), o1 = pg8::bf_hi(gu.x) * (gn[1] * acc[ni][1] + bsv);
            const float o2 = pg8::bf_lo(gu.y) * (gn[2] * acc[ni][2] + bsv), o3 = pg8::bf_hi(gu.y) * (gn[3] * acc[ni][3] + bsv);
            v2u o; o.x = pg8::cvt_pk_bf16(o0, o1); o.y = pg8::cvt_pk_bf16(o2, o3);
            *(GAS v2u*)(GM + (size_t)row * GMW + c0) = o; }
        __syncthreads();
    }
}

namespace att {
constexpr float SCALE = 0.07216878364870322f;
constexpr float THR = 8.f;
constexpr int SHM_V = 16384, SHM_K = 24576;
constexpr int OFF_V = 0, OFF_K = 2 * SHM_V, OFF_S = OFF_K + 2 * SHM_K;
#define KSWZ(row, colB) ((row) * 384 + ((colB) ^ ((((row) >> 1) & 7) << 4)))
#define SBAR() __builtin_amdgcn_sched_barrier(0)
__device__ __forceinline__ int crow(int r, int hi) { return (r & 3) + 8 * (r >> 2) + 4 * hi; }
__device__ __forceinline__ unsigned cvtpk(float lo, float hi) { unsigned r; asm volatile("s_nop 1\n\tv_cvt_pk_bf16_f32 %0, %1, %2" : "=v"(r) : "v"(lo), "v"(hi)); return r; }
__device__ __forceinline__ void partialSM(f32x16& p0, f32x16& p1, float& m_reg, float& mn, float& alpha) {
    constexpr float C = SCALE * 1.4426950408889634f;
    float pmax = p0[0];
#pragma unroll
    for (int r = 1; r < 16; ++r) pmax = fmaxf(pmax, p0[r]);
#pragma unroll
    for (int r = 0; r < 16; ++r) pmax = fmaxf(pmax, p1[r]);
    { auto rr = __builtin_amdgcn_permlane32_swap(__float_as_uint(pmax), __float_as_uint(pmax), false, false);
      pmax = fmaxf(__uint_as_float(rr[0]), __uint_as_float(rr[1])); }
    if (__builtin_expect(__all(pmax - m_reg <= THR / SCALE), 1)) { mn = m_reg; alpha = 1.f; }
    else { mn = fmaxf(m_reg, pmax); alpha = __builtin_amdgcn_exp2f((m_reg - mn) * C); m_reg = mn; }
    const float mnC = -mn * C;
#pragma unroll
    for (int r = 0; r < 16; ++r) p0[r] = fmaf(p0[r], C, mnC);
#pragma unroll
    for (int r = 0; r < 16; ++r) p1[r] = fmaf(p1[r], C, mnC);
#pragma unroll
    for (int r = 0; r < 16; ++r) p0[r] = __builtin_amdgcn_exp2f(p0[r]);
}
__device__ __forceinline__ void finishSM(f32x16& p0, f32x16& p1, float alpha, float& l_reg, bf16x8& pa0, bf16x8& pa1, bf16x8& pa2, bf16x8& pa3) {
#pragma unroll
    for (int r = 0; r < 16; ++r) p1[r] = __builtin_amdgcn_exp2f(p1[r]);
    float ps = 0;
#pragma unroll
    for (int r = 0; r < 16; ++r) ps += p0[r];
#pragma unroll
    for (int r = 0; r < 16; ++r) ps += p1[r];
    { auto rr = __builtin_amdgcn_permlane32_swap(__float_as_uint(ps), __float_as_uint(ps), false, false);
      ps = __uint_as_float(rr[0]) + __uint_as_float(rr[1]); }
    l_reg = l_reg * alpha + ps;
#define PK4(P, BASE, OUT) do { unsigned a0 = cvtpk(P[BASE + 0], P[BASE + 1]), a1 = cvtpk(P[BASE + 2], P[BASE + 3]);   \
    unsigned b0 = cvtpk(P[BASE + 4], P[BASE + 5]), b1 = cvtpk(P[BASE + 6], P[BASE + 7]);                              \
    auto r0 = __builtin_amdgcn_permlane32_swap(a0, b0, false, false); auto r1 = __builtin_amdgcn_permlane32_swap(a1, b1, false, false); \
    v4u w = {r0[0], r1[0], r0[1], r1[1]}; OUT = __builtin_bit_cast(bf16x8, w); } while (0)
    PK4(p0, 0, pa0); PK4(p0, 8, pa1); PK4(p1, 0, pa2); PK4(p1, 8, pa3);
#undef PK4
}
__device__ __forceinline__ void qkt(f32x16& p0, f32x16& p1, const LAS unsigned char* Ks, const bf16x8 (&qr)[12], int r32, int hi) {
    p0 = f32x16{}; p1 = f32x16{};
    bf16x8 b0 = *(const LAS bf16x8*)(Ks + KSWZ(r32, (hi * 8) * 2)), b1 = *(const LAS bf16x8*)(Ks + KSWZ(32 + r32, (hi * 8) * 2));
#pragma unroll
    for (int d0 = 0; d0 < 12; ++d0) { const int cn = ((d0 + 1) * 16 + hi * 8) * 2; bf16x8 n0 = b0, n1 = b1;
        if (d0 < 11) { n0 = *(const LAS bf16x8*)(Ks + KSWZ(r32, cn)); n1 = *(const LAS bf16x8*)(Ks + KSWZ(32 + r32, cn)); }
        SBAR();
        p0 = __builtin_amdgcn_mfma_f32_32x32x16_bf16(b0, qr[d0], p0, 0, 0, 0);
        p1 = __builtin_amdgcn_mfma_f32_32x32x16_bf16(b1, qr[d0], p1, 0, 0, 0);
        SBAR();
        b0 = n0; b1 = n1; }
}
__device__ __forceinline__ int v_st(int k, int c) { const int kk = (k & ~0xC) | ((k & 4) << 1) | ((k & 8) >> 1); return ((kk >> 3) * 4 + (c >> 5)) * 512 + ((kk & 7) * 32 + (c & 31)) * 2; }
__device__ __forceinline__ int v_rd_base(int lane) { return ((lane & 3) << 3) | (((lane >> 2) & 3) << 6) | (((lane >> 4) & 1) << 5) | (((lane >> 5) & 1) << 8); }
constexpr int v_rd_off(int d0, int ks, int half) { return d0 * 512 + ks * 4096 + half * 2048; }
template <int OFF> __device__ __forceinline__ s16x4 tr_read(int vb) {
    s16x4 r; asm volatile("ds_read_b64_tr_b16 %0, %1 offset:%2" : "=&v"(r) : "v"(vb), "i"(OFF) : "memory"); return r;
}
__device__ __forceinline__ void pv_all(f32x16 (&o)[4], int vb, bf16x8 pa0, bf16x8 pa1, bf16x8 pa2, bf16x8 pa3) {
#define PK(L, H) (bf16x8){L[0], L[1], L[2], L[3], H[0], H[1], H[2], H[3]}
#define TRSET(S, D0) do { S##l0 = tr_read<v_rd_off(D0, 0, 0)>(vb); S##h0 = tr_read<v_rd_off(D0, 0, 1)>(vb); S##l1 = tr_read<v_rd_off(D0, 1, 0)>(vb); S##h1 = tr_read<v_rd_off(D0, 1, 1)>(vb); \
                          S##l2 = tr_read<v_rd_off(D0, 2, 0)>(vb); S##h2 = tr_read<v_rd_off(D0, 2, 1)>(vb); S##l3 = tr_read<v_rd_off(D0, 3, 0)>(vb); S##h3 = tr_read<v_rd_off(D0, 3, 1)>(vb); } while (0)
#define PVMMA(S, od) do { od = __builtin_amdgcn_mfma_f32_32x32x16_bf16(pa0, PK(S##l0, S##h0), od, 0, 0, 0); od = __builtin_amdgcn_mfma_f32_32x32x16_bf16(pa1, PK(S##l1, S##h1), od, 0, 0, 0); \
                          od = __builtin_amdgcn_mfma_f32_32x32x16_bf16(pa2, PK(S##l2, S##h2), od, 0, 0, 0); od = __builtin_amdgcn_mfma_f32_32x32x16_bf16(pa3, PK(S##l3, S##h3), od, 0, 0, 0); } while (0)
#define LWAIT(n) do { asm volatile("s_waitcnt lgkmcnt(" #n ")" ::: "memory"); SBAR(); } while (0)
    s16x4 Al0, Ah0, Al1, Ah1, Al2, Ah2, Al3, Ah3, Bl0, Bh0, Bl1, Bh1, Bl2, Bh2, Bl3, Bh3;
    TRSET(A, 0); TRSET(B, 1); LWAIT(8); PVMMA(A, o[0]); SBAR();
    TRSET(A, 2); LWAIT(8); PVMMA(B, o[1]); SBAR();
    TRSET(B, 3); LWAIT(8); PVMMA(A, o[2]); SBAR();
    LWAIT(0); PVMMA(B, o[3]);
#undef PK
#undef TRSET
#undef PVMMA
#undef LWAIT
}
__device__ __forceinline__ void attn_unit(const gbf16* Qb, const gbf16* Kh, const gbf16* Rh, const gbf16* Vh, gbf16* Ob, int seq, LAS unsigned char* lds, int tid) {
    constexpr int LDQ = 3072, LDK = 2048, LDR = 64, LDO = 2048;
    const int wid = tid >> 6, lane = tid & 63, r32 = lane & 31, hi = lane >> 5;
    LAS unsigned char* V_lds = lds + OFF_V; LAS unsigned char* K_lds = lds + OFF_K;
    LAS float* wsf = (LAS float*)(lds + OFF_S) + wid * 64; LAS float* li_l = wsf; LAS float* al_l = wsf + 32;
    float m_reg = -1e30f, l_reg = 0.f; f32x16 o[4] = {}; bf16x8 qr[12];
    const GAS bf16* Qw = Qb + (size_t)(wid * 32 + r32) * LDQ + hi * 8;
#pragma unroll
    for (int d0 = 0; d0 < 12; ++d0) qr[d0] = *(const GAS bf16x8*)(Qw + d0 * 16);
    const int sr = tid >> 4, sc = (tid & 15) * 8, vst0 = v_st(sr, sc), vst1 = v_st(32 + sr, sc);
    const int rr = tid >> 3, rc = (tid & 7) * 8;
    const int vb0 = (int)(unsigned)(uintptr_t)V_lds + v_rd_base(lane);
    bf16x8 vs0, vs1, ks0, ks1, ks2;
    const unsigned vo_kv = (unsigned)(sr * LDK + sc) * 2u, vo_r = (unsigned)(rr * LDR + rc) * 2u;
#define SLOADK(k0) do { const GAS char* kb_ = (const GAS char*)Kh + (size_t)(k0) * (LDK * 2); const GAS char* rb_ = (const GAS char*)Rh + (size_t)(k0) * (LDR * 2); \
    unsigned o1_ = vo_kv, o2_ = vo_r; asm volatile("" : "+v"(o1_), "+v"(o2_));     \
    ks0 = *(const GAS bf16x8*)(kb_ + o1_); ks1 = *(const GAS bf16x8*)(kb_ + 32 * LDK * 2 + o1_); ks2 = *(const GAS bf16x8*)(rb_ + o2_); } while (0)
#define SLOADV(k0) do { const GAS char* vb_ = (const GAS char*)Vh + (size_t)(k0) * (LDK * 2); unsigned o1_ = vo_kv; asm volatile("" : "+v"(o1_)); \
    vs0 = *(const GAS bf16x8*)(vb_ + o1_); vs1 = *(const GAS bf16x8*)(vb_ + 32 * LDK * 2 + o1_); } while (0)
#define SWRITEK(b) do { *(LAS bf16x8*)(K_lds + (b) * SHM_K + KSWZ(sr, sc * 2)) = ks0; *(LAS bf16x8*)(K_lds + (b) * SHM_K + KSWZ(32 + sr, sc * 2)) = ks1; \
    *(LAS bf16x8*)(K_lds + (b) * SHM_K + KSWZ(rr, 256 + rc * 2)) = ks2; } while (0)
#define SWRITEV(b) do { *(LAS bf16x8*)(V_lds + (b) * SHM_V + vst0) = vs0; *(LAS bf16x8*)(V_lds + (b) * SHM_V + vst1) = vs1; } while (0)
    const int NT = seq / 64, grp = __builtin_amdgcn_readfirstlane(wid >> 2);
    SLOADK(0); SWRITEK(0);
    SLOADK(64); SLOADV(0);
    f32x16 p0, p1; float mn, al; bf16x8 pa0, pa1, pa2, pa3;
#define ST_BAR() do { LDS_WAIT(); __builtin_amdgcn_s_barrier(); asm volatile("" ::: "memory"); } while (0)
#define ST_WRITES(j) do { if ((j) + 1 < NT) SWRITEK(((j) + 1) & 1); SWRITEV((j) & 1); if ((j) + 2 < NT) SLOADK(((j) + 2) * 64); if ((j) + 1 < NT) SLOADV(((j) + 1) * 64); } while (0)
#define ST_PV(j) do { const int vb = vb0 + ((j) & 1) * SHM_V; SBAR(); \
        pv_all(o, vb, pa0, pa1, pa2, pa3); } while (0)
#define ST_QK(j) do { SBAR(); qkt(p0, p1, K_lds + ((j) & 1) * SHM_K, qr, r32, hi); } while (0)
#define ST_SM() do { partialSM(p0, p1, m_reg, mn, al); \
        if (__any(al < 1.f)) { if (hi == 0) al_l[r32] = al; LDS_WAIT(); \
            _Pragma("unroll") for (int d = 0; d < 4; ++d) _Pragma("unroll") for (int r = 0; r < 16; ++r) o[d][r] *= al_l[crow(r, hi)]; } \
        finishSM(p0, p1, al, l_reg, pa0, pa1, pa2, pa3); SBAR(); } while (0)
    if (grp == 0) {
        ST_BAR(); ST_QK(0); ST_BAR(); ST_WRITES(0); ST_SM();
        for (int j = 1; j < NT; ++j) { ST_BAR(); ST_PV(j - 1); ST_QK(j); ST_BAR(); ST_WRITES(j); ST_SM(); }
        ST_BAR(); ST_PV(NT - 1); ST_BAR();
    } else {
        ST_BAR(); ST_BAR(); ST_WRITES(0); ST_QK(0); ST_BAR(); ST_SM();
        for (int j = 1; j < NT; ++j) { ST_BAR(); ST_WRITES(j); ST_PV(j - 1); ST_QK(j); ST_BAR(); ST_SM(); }
        ST_BAR(); ST_PV(NT - 1);
    }
#undef ST_BAR
#undef ST_WRITES
#undef ST_PV
#undef ST_QK
#undef ST_SM
    if (hi == 0) li_l[r32] = l_reg; LDS_WAIT();
    float rli[16];
#pragma unroll
    for (int r = 0; r < 16; ++r) rli[r] = __builtin_amdgcn_rcpf(li_l[crow(r, hi)]);
    GAS bf16* Ow = Ob + (size_t)(wid * 32) * LDO;
#pragma unroll
    for (int r = 0; r < 16; ++r) { const int orow = crow(r, hi);
#pragma unroll
        for (int d0 = 0; d0 < 4; ++d0) Ow[(size_t)orow * LDO + d0 * 32 + r32] = (bf16)f2bf(o[d0][r] * rli[r]); }
    LDS_WAIT();
#undef SLOADK
#undef SLOADV
#undef SWRITEK
#undef SWRITEV
}
#undef KSWZ
}

__device__ __forceinline__ void attn_phase(const Frame& F, const gbf16* Q, const gbf16* KN, const gbf16* KR, const gbf16* V, gbf16* AO, int S) {
    for (int k_ = 0; k_ < 4; ++k_) {
        const int ii = (F.bid >> 3) + 32 * k_, h = ii >> 3, r0 = F.xc * 2048 + (ii & 7) * 256, b = r0 / S, qb = (r0 % S) >> 8; const size_t rb = (size_t)b * S;
        att::attn_unit(Q + (rb + (size_t)qb * 256) * 3072 + h * 192, KN + rb * 2048 + h * 128, KR + rb * 64, V + rb * 2048 + h * 128,
                       AO + (rb + (size_t)qb * 256) * 2048 + h * 128, S, F.lds, F.tid);
    }
}

__device__ __forceinline__ int lane_now() { int ln; asm volatile("v_mbcnt_lo_u32_b32 %0, -1, 0\n\tv_mbcnt_hi_u32_b32 %0, -1, %0" : "=v"(ln)); return ln; }
__device__ __forceinline__ int opq(int k) { asm volatile("" : "+s"(k)); return k; }
__device__ __forceinline__ unsigned char* opqp(unsigned char* p) { asm volatile("" : "+s"(p)); return p; }
__device__ __forceinline__ const gf32* opqg(const gf32* p) { asm volatile("" : "+s"(p)); return p; }
__device__ __forceinline__ unsigned* opqu(unsigned* p) { asm volatile("" : "+s"(p)); return p; }
__device__ __forceinline__ Frame make_frame(LAS unsigned char* l, int wave_sgpr) {
    Frame F; int ln = lane_now(); int wv = wave_sgpr; asm volatile("" : "+s"(wv));
    int b = __builtin_amdgcn_readfirstlane(*(volatile LAS int*)(l + MISC_OFF + 14 * 4)); asm volatile("" : "+s"(b)); int G = gridDim.x; asm volatile("" : "+s"(G));
    F.lds = l; F.tid = wv * 64 + ln; F.lane = ln; F.wave = wv; F.G = G; F.bid = b; F.gw = b * NWAVES + wv; F.ngw = G * NWAVES; F.xc = b & 7; F.wx = (b >> 3) * NWAVES + wv; return F; }
#define INP(k) ((const gf32*)args.in[opq(k)])
#define WSP(T, off) ((GAS T*)(w_ + (off)))
#define GEMM_PHASE_MW(EPI, Wgm, Mrows, Aptr, Bptr, Ncols, Kdim, ...) do { pg8::Gemm gm_{Aptr, Bptr, Mrows, Ncols, Kdim}; pg8::StaticOrder So_; So_.init(Mrows, Ncols, F.G, F.bid, Wgm); EPI E_{__VA_ARGS__}; \
    pg8::gemm_phase<EPI, pg8::StaticOrder, true, true>(F.lds + RING_OFF, gm_, So_, E_, F.tid); } while (0)
#define GEMM_PHASE_M(EPI, ...) GEMM_PHASE_MW(EPI, 8, __VA_ARGS__)
#define GEMM_PHASE(EPI, ...) GEMM_PHASE_MW(EPI, 8, MROWS, __VA_ARGS__)
#define M2 (2 * MROWS)
#define PHASE_BEGIN() unsigned char* w_ = opqp(args.ws); const Frame F = make_frame((LAS unsigned char*)lds, wave_id)
#define FOR_ROWS2() _Pragma("unroll 1") for (int it_ = 0; it_ < 16; ++it_) if (const int gg_ = it_ >> 3, m_ = F.xc * 2048 + F.wx + 256 * (it_ & 7), mg_ = gg_ * MROWS + m_; true)


#define GRID_BAR() do { XcdBarrier b2_ = bar; b2_.bar = opqu(b2_.bar); b2_.x = (unsigned)opq((int)b2_.x); { int wv_ = wave_id; asm volatile("" : "+s"(wv_)); int ln_ = lane_now(); b2_.leader = (wv_ == 0 && ln_ == 0); } xcd_barrier(b2_); } while (0)
template <int g> __device__ __forceinline__ void mixer_program(const Args args, unsigned char* lds, const int wave_id, const XcdBarrier bar) {
#define XPTR() ((gf32*)(args.out + (size_t)g * MROWS * D))
#define XNG() (WSP(bf16, WS_XN) + (size_t)g * MROWS * D)
#define SEQ() (g ? 8192 : 2048)
#define SSG() ((gf32*)(w_ + WS_SS + (size_t)g * 196608))
#define SXG(j) ((gf32*)(w_ + WS_SX + (size_t)(j) * 131072 + (size_t)g * 65536))
        { PHASE_BEGIN();
            GEMM_PHASE(pg8::EpiZ, XNG(), WSP(bf16, WS_WIN), INWP, D, WSP(bf16, WS_GU), WSP(bf16, WS_GV), WSP(bf16, WS_QL), WSP(bf16, WS_KVL), WSP(bf16, WS_KR), WSP(bf16, WS_GA), WSP(bf16, WS_GB),
                       WSP(float, WS_COS), WSP(float, WS_SIN), SEQ() - 1, SSG(), SXG(1)); }
        GRID_BAR();
        { PHASE_BEGIN(); gmlp_phase(F, INP(11), INP(12), INP(10), WSP(bf16, WS_GU), WSP(bf16, WS_GV), SSG(), WSP(bf16, WS_GM)); }
        { PHASE_BEGIN(); GEMM_PHASE(pg8::EpiQ, WSP(bf16, WS_QL), WSP(bf16, WS_WUQ), QW, QLR, WSP(bf16, WS_Q), SSG() + 16384, WSP(float, WS_COS), WSP(float, WS_SIN), SEQ() - 1); }
        { PHASE_BEGIN(); GEMM_PHASE(pg8::EpiKV, WSP(bf16, WS_KVL), WSP(bf16, WS_WUKV), KVW, KVR, WSP(bf16, WS_KN), WSP(bf16, WS_V), SSG() + 32768); }
        GRID_BAR();
        { PHASE_BEGIN(); attn_phase(F, WSP(bf16, WS_Q), WSP(bf16, WS_KN), WSP(bf16, WS_KR), WSP(bf16, WS_V), WSP(bf16, WS_AO), SEQ()); }
        GRID_BAR();
        { PHASE_BEGIN(); GEMM_PHASE(pg8::EpiGate<1>, WSP(bf16, WS_GM), WSP(bf16, WS_WOA), D, GMW, WSP(bf16, WS_M1), WSP(bf16, WS_GA), nullptr, D); }
        { PHASE_BEGIN(); GEMM_PHASE(pg8::EpiGate<2>, WSP(bf16, WS_AO), WSP(bf16, WS_WOB), D, NH * 128, WSP(bf16, WS_MG), WSP(bf16, WS_GB), WSP(bf16, WS_M1), D); }
        GRID_BAR();
        { PHASE_BEGIN(); GEMM_PHASE(pg8::EpiResid<false>, WSP(bf16, WS_MG), WSP(bf16, WS_WO), D, D, XNG(), SXG(2)); }
#undef XPTR
#undef XNG
#undef SEQ
#undef SSG
#undef SXG
}

__device__ __forceinline__ void ffn1_program(const Args args, unsigned char* lds, const int wave_id, const XcdBarrier bar) {
        { PHASE_BEGIN(); GEMM_PHASE_M(pg8::EpiSwiGLU, M2, WSP(bf16, WS_XN), WSP(bf16, WS_WF1U), 2 * DFF, D, WSP(bf16, WS_H), DFF, (const gf32*)(w_ + WS_SX)); }
        GRID_BAR();
        { PHASE_BEGIN(); GEMM_PHASE_MW(pg8::EpiResid<true>, 2, M2, WSP(bf16, WS_H), WSP(bf16, WS_WF1D), D, DFF, WSP(bf16, WS_XN), (gf32*)(w_ + WS_SX + 131072)); }
        GRID_BAR();
}
__device__ __forceinline__ void tail_program(const Args args, unsigned char* lds, const int wave_id, const XcdBarrier bar) {
        { PHASE_BEGIN(); GEMM_PHASE_M(pg8::EpiSwiGLU, M2, WSP(bf16, WS_XN), WSP(bf16, WS_WF2U), 2 * DFF, D, WSP(bf16, WS_H), DFF, (const gf32*)(w_ + WS_SX + 2 * 131072)); }
        GRID_BAR();
        { PHASE_BEGIN(); GEMM_PHASE_MW(pg8::EpiResid<true>, 2, M2, WSP(bf16, WS_H), WSP(bf16, WS_WF2D), D, DFF, WSP(bf16, WS_XN), (gf32*)(w_ + WS_SX + 3 * 131072)); }
        GRID_BAR();
        { PHASE_BEGIN(); GEMM_PHASE_M(pg8::EpiGate<0>, M2, WSP(bf16, WS_PB), WSP(bf16, WS_WPP), D, opq(PLE), WSP(bf16, WS_PP), nullptr, nullptr, D); }
        { PHASE_BEGIN(); GEMM_PHASE_M(pg8::EpiPleGate, M2, WSP(bf16, WS_XN), WSP(bf16, WS_WPG), D, D, WSP(bf16, WS_TT), WSP(bf16, WS_PP), D, (GAS float*)(w_ + WS_SST), (const gf32*)(w_ + WS_SX + 3 * 131072)); }
        GRID_BAR();
        { PHASE_BEGIN(); gf32* X = (gf32*)args.out; const gbf16* XR = WSP(bf16, WS_XN); const gbf16* TT = WSP(bf16, WS_TT); const gf32* gp = INP(27); const gf32* gf = INP(28); const gf32* sst = (const gf32*)(w_ + WS_SST);
            FOR_ROWS2() { const int m = mg_;
                const GAS v2u* xr = (const GAS v2u*)(XR + (size_t)m * D) + F.lane; const GAS v2u* tr = (const GAS v2u*)(TT + (size_t)m * D) + F.lane;
                const GAS f32x4* g1 = (const GAS f32x4*)opqg(gp) + F.lane; const GAS f32x4* g2 = (const GAS f32x4*)opqg(gf) + F.lane;
                f32x4 xv[16]; const float rt = 1.0f / sqrtf(sst[m] * (1.f / D) + EPS); float sx = 0.f;
#pragma unroll
                for (int j = 0; j < 16; ++j) { const f32x4 gg = g1[64 * j]; const v2u tw = __builtin_nontemporal_load(tr + 64 * j); const f32x4 t = (f32x4){pg8::bf_lo(tw.x), pg8::bf_hi(tw.x), pg8::bf_lo(tw.y), pg8::bf_hi(tw.y)};
                    const v2u xq = __builtin_nontemporal_load(xr + 64 * j); xv[j] = (f32x4){pg8::bf_lo(xq.x), pg8::bf_hi(xq.x), pg8::bf_lo(xq.y), pg8::bf_hi(xq.y)} + t * rt * gg; sx += (xv[j].x * xv[j].x + xv[j].y * xv[j].y) + (xv[j].z * xv[j].z + xv[j].w * xv[j].w); }
                const float rx = 1.0f / sqrtf(wave_sum(sx) * (1.f / D) + EPS);
                GAS f32x4* orow = (GAS f32x4*)(X + (size_t)m * D) + F.lane;
#pragma unroll
                for (int j = 0; j < 16; ++j) { const f32x4 gg = g2[64 * j]; __builtin_nontemporal_store(xv[j] * rx * gg, orow + 64 * j); }
            } }
}

__global__ void __launch_bounds__(NWAVES * 64, 2) fwd(Args args) {
    extern __shared__ __attribute__((aligned(16))) unsigned char lds[];
    volatile LAS unsigned* MISC = (volatile LAS unsigned*)((LAS unsigned char*)lds + MISC_OFF);
    const int wave_id = __builtin_amdgcn_readfirstlane((int)threadIdx.x >> 6);
    { const int ln0 = lane_now();
      for (int u = wave_id * 64 + ln0; u < (LDS_BYTES - LDSCTL_OFF) / 4; u += NWAVES * 64) ((LAS unsigned*)((LAS unsigned char*)lds + LDSCTL_OFF))[u] = 0u; }
    __syncthreads();
    XcdBarrier bar = xcd_barrier_post((unsigned*)(args.ws + WS_CTL) + CW_BAR, MISC + 8, false);
    if (wave_id == 0 && lane_now() == 0) {
        (void)xb_add(&bar.bar[XB_XCNT(bar.x)], 1u);
        const unsigned rank = xb_add((unsigned*)(args.ws + WS_CTL) + CW_XRANK + 64 * (bar.x & 7u), 1u);
        MISC[12] = bar.x; MISC[13] = rank; MISC[14] = blockIdx.x;
    }
    __syncthreads();

    {
        unsigned char* w_ = opqp(args.ws); const Frame F = make_frame((LAS unsigned char*)lds, wave_id);
        LAS float* scr = (LAS float*)(F.lds + RING_OFF + F.wave * 16384);
        int base = 0;
        tr_matrix<1>(F, INP(5), INP(6), DFF, D, 2 * DFF, WSP(bf16, WS_WF1U), INP(4), scr, base);
        tr_matrix<0>(F, INP(7), nullptr, D, DFF, D, WSP(bf16, WS_WF1D), nullptr, scr, base);
        tr_matrix<1>(F, INP(21), INP(22), DFF, D, 2 * DFF, WSP(bf16, WS_WF2U), INP(20), scr, base);
        tr_matrix<0>(F, INP(23), nullptr, D, DFF, D, WSP(bf16, WS_WF2D), nullptr, scr, base);
        tr_matrix<2>(F, INP(9), nullptr, INW, D, INWP, WSP(bf16, WS_WIN), INP(8), scr, base);
        tr_matrix<0>(F, INP(13), nullptr, D, GMW, D, WSP(bf16, WS_WOA), nullptr, scr, base);
        tr_matrix<0>(F, INP(18), nullptr, D, NH * 128, D, WSP(bf16, WS_WOB), nullptr, scr, base);
        tr_matrix<3>(F, INP(15), nullptr, QW, QLR, QW, WSP(bf16, WS_WUQ), INP(14), scr, base);
        tr_matrix<0>(F, INP(17), nullptr, KVW, KVR, KVW, WSP(bf16, WS_WUKV), INP(16), scr, base);
        tr_matrix<0>(F, INP(19), nullptr, D, D, D, WSP(bf16, WS_WO), nullptr, scr, base);
        tr_matrix<0>(F, INP(25), nullptr, D, D, D, WSP(bf16, WS_WPG), INP(24), scr, base);
        tr_matrix<0>(F, INP(26), nullptr, D, PLE, D, WSP(bf16, WS_WPP), nullptr, scr, base);
        gf32* COS = WSP(float, WS_COS); gf32* SIN = WSP(float, WS_SIN);
        for (int i = F.bid * (NWAVES * 64) + F.tid; i < 8192 * 32; i += F.G * NWAVES * 64) {
            const int s = i >> 5, j = i & 31;
            const float inv = 1.0f / powf(10000.0f, (float)(2 * j) / 64.0f);
            const float ang = (float)s * inv;
            COS[i] = (float)cos((double)ang); SIN[i] = (float)sin((double)ang);
        }
        { const gf32* x0 = INP(0); const gf32* x1 = INP(1); const gf32* p0 = INP(2); const gf32* p1 = INP(3); gbf16* XR = WSP(bf16, WS_XN); gbf16* PB = WSP(bf16, WS_PB); gf32* SX0 = (gf32*)(w_ + WS_SX);
          FOR_ROWS2() { row_to_bf16_ss((gg_ ? x1 : x0) + (size_t)m_ * D, XR + (size_t)mg_ * D, SX0 + mg_, F.lane);
              const f32x4 pv = *((const GAS f32x4*)((gg_ ? p1 : p0) + (size_t)m_ * PLE) + F.lane); v2u w; w.x = pk2(pv.x, pv.y); w.y = pk2(pv.z, pv.w);
              *((GAS v2u*)(PB + (size_t)mg_ * PLE) + F.lane) = w; } }
    }
    GRID_BAR();
    if (wave_id == 0 && lane_now() == 0) {
        unsigned* cw = (unsigned*)(args.ws + WS_CTL) + CW_XRANK; bool ok = (gridDim.x == 256u);
        for (int j = 0; j < 8; ++j) ok = ok && (xb_ld(cw + 64 * j) == 32u);
        const unsigned x = MISC[12], rank = MISC[13];
        MISC[14] = (ok && x < 8u && rank < 32u) ? rank * 8u + x : blockIdx.x;
    }
    __syncthreads();


    ffn1_program(args, lds, wave_id, bar);
    mixer_program<0>(args, lds, wave_id, bar);
    mixer_program<1>(args, lds, wave_id, bar);
    GRID_BAR();
    tail_program(args, lds, wave_id, bar);
#undef GRID_BAR
}

extern "C" void kernel_launch(void* const* d_in, const int* in_sizes, int n_in, void* d_out, int out_size, void* d_ws, size_t ws_size, hipStream_t stream) {
    static int grid = 0;
    if (grid == 0) {
        if (n_in != 29 || in_sizes[0] != MROWS * D || out_size != 2 * MROWS * D || ws_size < WS_END) {
            fprintf(stderr, "kernel_launch: shape mismatch n_in %d in0 %d out %d ws %zu (need %zu)\n", n_in, n_in > 0 ? in_sizes[0] : -1, out_size, ws_size, (size_t)WS_END); grid = -1; return; }
        int dev = 0, cus = 0, per_cu = 0;
        if (hipGetDevice(&dev) != hipSuccess || hipDeviceGetAttribute(&cus, hipDeviceAttributeMultiprocessorCount, dev) != hipSuccess) { grid = -1; return; }
        if (hipFuncSetAttribute((const void*)fwd, hipFuncAttributeMaxDynamicSharedMemorySize, LDS_BYTES) != hipSuccess) { fprintf(stderr, "kernel_launch: hipFuncSetAttribute failed\n"); grid = -1; return; }
        if (hipOccupancyMaxActiveBlocksPerMultiprocessor(&per_cu, (const void*)fwd, NWAVES * 64, LDS_BYTES) != hipSuccess || per_cu < 1)
            fprintf(stderr, "kernel_launch: note: occupancy query reports %d workgroups per CU\n", per_cu);
        (void)hipGetLastError();
        if (cus != 256) { fprintf(stderr, "kernel_launch: built for 256 CUs (one workgroup per CU), device has %d; nothing launched\n", cus); grid = -1; return; }
        grid = cus;
    }
    if (grid < 0) return;
    if (hipMemsetAsync((char*)d_ws + WS_CTL, 0, CTL_ZERO_BYTES, stream) != hipSuccess) { fprintf(stderr, "kernel_launch: memset failed\n"); return; }
    Args a{};
    for (int i = 0; i < 29; ++i) a.in[i] = (const float*)d_in[i];
    a.out = (float*)d_out; a.ws = (unsigned char*)d_ws;
    hipLaunchKernelGGL(fwd, dim3(grid), dim3(NWAVES * 64), LDS_BYTES, stream, a);
    const hipError_t le = hipPeekAtLastError();
    if (le != hipSuccess) fprintf(stderr, "kernel_launch: launch failed: %s\n", hipGetErrorName(le));
}
```

```cpp
#include <hip/hip_runtime.h>
#include <cstdio>
#include <cstdint>


namespace pg8 {
#define PG8_LAS __attribute__((address_space(3)))
#define PG8_GAS __attribute__((address_space(1)))
typedef unsigned short bf16_t;
typedef short bf16x8 __attribute__((ext_vector_type(8)));
typedef float f32x4 __attribute__((ext_vector_type(4)));
typedef unsigned u32x4 __attribute__((ext_vector_type(4)));
typedef unsigned u32x2 __attribute__((ext_vector_type(2)));
constexpr int RS_OFF = 133120;
constexpr int BM = 256, BK = 64, HALF = 128, HTB = HALF * BK * 2  , STAGE_BYTES = 8 * HTB, NXCD = 8, WGM = 8;

__host__ __device__ __forceinline__ int lds_byte(int r, int c) { const int st = (r >> 4) * 2 + (c >> 5), rr = r & 15, cc = c & 31, ob = rr * 64 + cc * 2; return st * 1024 + (ob ^ (((ob >> 9) & 1) << 5)); }
__host__ __device__ __forceinline__ void stage_rc(int b, int& R, int& C) { const int st = b / 1024, sb = b % 1024, swz = sb ^ (((sb >> 9) & 1) << 5); R = (st >> 1) * 16 + swz / 64; C = (st & 1) * 32 + (swz % 64) / 2; }
__host__ __device__ __forceinline__ int perm32(int rho) { const int n = rho >> 4, i = rho & 15; return 8 * (i >> 2) + 4 * n + (i & 3); }

struct Unit { int pm, pn; };
struct Gemm { const PG8_GAS bf16_t* A; const PG8_GAS bf16_t* Bt; int M, N, K; };

struct StaticOrder {
    int nM, nN, nwg, G, c, wgm;
    __host__ __device__ void init(int M, int N, int G_, int c_, int wgm_ = WGM) { nM = M / BM; nN = N / BM; nwg = nM * nN; G = G_; c = c_; wgm = wgm_; }
    __host__ __device__ bool next(int i, Unit& u) const {
        const long L = (long)i * G + c; if (L >= nwg) return false;
        int wgid = (int)L; { const int q = nwg / NXCD, r = nwg % NXCD, xcd = wgid % NXCD, off = wgid / NXCD; wgid = (xcd < r ? xcd * (q + 1) : r * (q + 1) + (xcd - r) * q) + off; }
        const int nig = wgm * nN, gid = wgid / nig, fm = gid * wgm, gsz = (nM - fm) < wgm ? (nM - fm) : wgm;
        u.pm = fm + ((wgid % nig) % gsz); u.pn = (wgid % nig) / gsz; return true;
    }
    __device__ __forceinline__ void a_ready(const Unit&) const {}
    __device__ __forceinline__ void done(const Unit&) const {}
};

typedef __bf16 bf16v2_t __attribute__((ext_vector_type(2)));
typedef float f32v2_t __attribute__((ext_vector_type(2)));
__device__ __forceinline__ unsigned cvt_pk_bf16(float lo, float hi) { const f32v2_t v = {lo, hi}; return __builtin_bit_cast(unsigned, __builtin_convertvector(v, bf16v2_t)); }
__device__ __forceinline__ u32x4 pack8(const f32x4 a, const f32x4 b) { u32x4 w; w.x = cvt_pk_bf16(a[0], a[1]); w.y = cvt_pk_bf16(a[2], a[3]); w.z = cvt_pk_bf16(b[0], b[1]); w.w = cvt_pk_bf16(b[2], b[3]); return w; }
__device__ __forceinline__ float bf_lo(unsigned w) { return __uint_as_float(w << 16); }
__device__ __forceinline__ float bf_hi(unsigned w) { return __uint_as_float(w & 0xffff0000u); }
__device__ __forceinline__ void unpack8(const u32x4 w, f32x4& a, f32x4& b) { a = (f32x4){bf_lo(w.x), bf_hi(w.x), bf_lo(w.y), bf_hi(w.y)}; b = (f32x4){bf_lo(w.z), bf_hi(w.z), bf_lo(w.w), bf_hi(w.w)}; }
__device__ __forceinline__ float sigmoid_f(float x) { return __builtin_amdgcn_rcpf(1.0f + __builtin_amdgcn_exp2f(-1.4426950408889634f * x)); }
__device__ __forceinline__ float silu_f(float x) { return x * sigmoid_f(x); }
__device__ __forceinline__ float gelu_tanh_f(float x) { const float y = 1.5957691216057308f * (x + 0.044715f * x * x * x); return x * sigmoid_f(y); }
__device__ __forceinline__ f32x4 sigmoid4(const f32x4 v) { return (f32x4){sigmoid_f(v[0]), sigmoid_f(v[1]), sigmoid_f(v[2]), sigmoid_f(v[3])}; }
__device__ __forceinline__ f32x4 gelu4(const f32x4 v) { return (f32x4){gelu_tanh_f(v[0]), gelu_tanh_f(v[1]), gelu_tanh_f(v[2]), gelu_tanh_f(v[3])}; }

__device__ __forceinline__ float ssq44(const f32x4 a, const f32x4 b) { return ((a[0] * a[0] + a[1] * a[1]) + (a[2] * a[2] + a[3] * a[3])) + ((b[0] * b[0] + b[1] * b[1]) + (b[2] * b[2] + b[3] * b[3])); }
__device__ __forceinline__ float row4_sum(float s) {
    s += __int_as_float(__builtin_amdgcn_ds_swizzle(__float_as_int(s), (16 << 10) | 0x1f));
    auto rr = __builtin_amdgcn_permlane32_swap(__float_as_uint(s), __float_as_uint(s), false, false); return __uint_as_float(rr[0]) + __uint_as_float(rr[1]); }
__device__ __forceinline__ float rstd_from_ss(float ss, float inv_n) { return __builtin_amdgcn_rsqf(ss * inv_n + 1e-6f); }
__device__ __forceinline__ void atomic_add_row(PG8_GAS float* p, float v) { asm volatile("global_atomic_add_f32 %0, %1, off sc1" :: "v"(p), "v"(v) : "memory"); }
struct EpiSwiGLU {
    static constexpr bool PERM = true, AFTER_DRAIN = false, ROWSCALE = true; static constexpr float INV_N = 1.f / 4096;
    PG8_GAS bf16_t* H; int ldh; const PG8_GAS float* SX;
    __device__ __forceinline__ void operator()(const f32x4 (&acc)[2][2][4][2], const Unit& u, int wr, int wc, int fr, int fq, const PG8_LAS float* rsl) const {
        const int row0 = u.pm * BM + wr * 64 + fr, col0 = u.pn * HALF + wc * 32 + 8 * fq;
#pragma unroll
        for (int ai = 0; ai < 2; ++ai)
#pragma unroll
            for (int m = 0; m < 4; ++m) { const int row = row0 + ai * HALF + m * 16; const float r = rsl[ai * 64 + m * 16 + fr];
                PG8_GAS bf16_t* rowp = H + (size_t)row * ldh + col0;
                const f32x4 g0 = acc[ai][0][m][0] * r, g1 = acc[ai][0][m][1] * r, u0 = acc[ai][1][m][0] * r, u1 = acc[ai][1][m][1] * r;
                const f32x4 v0 = (f32x4){silu_f(g0[0]) * u0[0], silu_f(g0[1]) * u0[1], silu_f(g0[2]) * u0[2], silu_f(g0[3]) * u0[3]};
                const f32x4 v1 = (f32x4){silu_f(g1[0]) * u1[0], silu_f(g1[1]) * u1[1], silu_f(g1[2]) * u1[2], silu_f(g1[3]) * u1[3]};
                *(PG8_GAS u32x4*)rowp = pack8(v0, v1);
            }
    }
};
struct EpiZ {
    static constexpr bool PERM = true, AFTER_DRAIN = false, ROWSCALE = true; static constexpr float INV_N = 1.f / 4096;
    PG8_GAS bf16_t *GU, *GV, *QL, *KVL, *KR, *GA, *GB; const PG8_GAS float* cs; const PG8_GAS float* sn; int smask; PG8_GAS float* SS; const PG8_GAS float* SX;
    __device__ __forceinline__ void operator()(const f32x4 (&acc)[2][2][4][2], const Unit& u, int wr, int wc, int fr, int fq, const PG8_LAS float* rsl) const {
        const int pn = u.pn, row0 = u.pm * BM + wr * 64 + fr, cw = wc * 32 + 8 * fq;
        if (pn < 16) {
            PG8_GAS bf16_t* dst = (pn < 8 ? GU : GV) + (pn & 7) * BM + cw;
#pragma unroll
            for (int ai = 0; ai < 2; ++ai)
#pragma unroll
                for (int m = 0; m < 4; ++m) { const int row = row0 + ai * HALF + m * 16; PG8_GAS bf16_t* rowp = dst + (size_t)row * 2048; float s = 0.f; const float r = rsl[ai * 64 + m * 16 + fr];
#pragma unroll
                    for (int bj = 0; bj < 2; ++bj) { const f32x4 t0 = gelu4(acc[ai][bj][m][0] * r), t1 = gelu4(acc[ai][bj][m][1] * r); s += ssq44(t0, t1); *(PG8_GAS u32x4*)(rowp + bj * HALF) = pack8(t0, t1); }
                    if (pn >= 8) { s = row4_sum(s); if (fq == 0) atomic_add_row(SS + row, s); } }
        } else if (pn < 22) {
            const bool isq = pn < 20; PG8_GAS bf16_t* dst = isq ? QL + (pn - 16) * BM + cw : KVL + (pn - 20) * BM + cw; const int ld = isq ? 1024 : 512;
#pragma unroll
            for (int ai = 0; ai < 2; ++ai)
#pragma unroll
                for (int m = 0; m < 4; ++m) { const int row = row0 + ai * HALF + m * 16; PG8_GAS bf16_t* rowp = dst + (size_t)row * ld; float s = 0.f; const float r = rsl[ai * 64 + m * 16 + fr];
#pragma unroll
                    for (int bj = 0; bj < 2; ++bj) { const f32x4 t0 = acc[ai][bj][m][0] * r, t1 = acc[ai][bj][m][1] * r; s += ssq44(t0, t1); *(PG8_GAS u32x4*)(rowp + bj * HALF) = pack8(t0, t1); }
                    s = row4_sum(s); if (fq == 0) atomic_add_row(SS + (isq ? 16384 : 32768) + row, s); }
        } else if (pn == 22) {
            if (wc == 0) {
#pragma unroll
                for (int ai = 0; ai < 2; ++ai)
#pragma unroll
                    for (int m = 0; m < 4; ++m) { const int row = row0 + ai * HALF + m * 16, s = row & smask;
                        const f32x4 c0 = *(const PG8_GAS f32x4*)(cs + (size_t)s * 32 + 8 * fq), c1 = *(const PG8_GAS f32x4*)(cs + (size_t)s * 32 + 8 * fq + 4);
                        const f32x4 s0 = *(const PG8_GAS f32x4*)(sn + (size_t)s * 32 + 8 * fq), s1 = *(const PG8_GAS f32x4*)(sn + (size_t)s * 32 + 8 * fq + 4);
                        const float r = rsl[ai * 64 + m * 16 + fr];
                        const f32x4 xa = acc[ai][0][m][0] * r, xb = acc[ai][0][m][1] * r, ya = acc[ai][1][m][0] * r, yb = acc[ai][1][m][1] * r;
                        PG8_GAS bf16_t* rowp = KR + (size_t)row * 64 + 8 * fq;
                        *(PG8_GAS u32x4*)rowp = pack8(xa * c0 - ya * s0, xb * c1 - yb * s1);
                        *(PG8_GAS u32x4*)(rowp + 32) = pack8(xa * s0 + ya * c0, xb * s1 + yb * c1); }
            }
        } else {
            const int t = pn - 23; PG8_GAS bf16_t* dst = (t < 16 ? GA : GB) + (t & 15) * BM + cw;
#pragma unroll
            for (int ai = 0; ai < 2; ++ai)
#pragma unroll
                for (int m = 0; m < 4; ++m) { const int row = row0 + ai * HALF + m * 16; PG8_GAS bf16_t* rowp = dst + (size_t)row * 4096; const float r = rsl[ai * 64 + m * 16 + fr];
#pragma unroll
                    for (int bj = 0; bj < 2; ++bj) *(PG8_GAS u32x4*)(rowp + bj * HALF) = pack8(sigmoid4(acc[ai][bj][m][0] * r), sigmoid4(acc[ai][bj][m][1] * r)); }
        }
    }
};
struct EpiQ {
    static constexpr bool PERM = true, AFTER_DRAIN = false, ROWSCALE = true; static constexpr float INV_N = 1.f / 1024;
    PG8_GAS bf16_t* Q; const PG8_GAS float* SX; const PG8_GAS float* cs; const PG8_GAS float* sn; int smask;
    __device__ __forceinline__ void operator()(const f32x4 (&acc)[2][2][4][2], const Unit& u, int wr, int wc, int fr, int fq, const PG8_LAS float* rsl) const {
        const int pn = u.pn, row0 = u.pm * BM + wr * 64 + fr;
        if (pn < 8) {
#pragma unroll
            for (int ai = 0; ai < 2; ++ai)
#pragma unroll
                for (int m = 0; m < 4; ++m) { const int row = row0 + ai * HALF + m * 16; const float r = rsl[ai * 64 + m * 16 + fr];
#pragma unroll
                    for (int bj = 0; bj < 2; ++bj) *(PG8_GAS u32x4*)(Q + (size_t)row * 3072 + (2 * pn + bj) * 192 + wc * 32 + 8 * fq) = pack8(acc[ai][bj][m][0] * r, acc[ai][bj][m][1] * r); }
        } else {
            const int head = 4 * (pn - 8) + wc;
#pragma unroll
            for (int ai = 0; ai < 2; ++ai)
#pragma unroll
                for (int m = 0; m < 4; ++m) { const int row = row0 + ai * HALF + m * 16, s = row & smask; const float r = rsl[ai * 64 + m * 16 + fr];
                    const f32x4 c0 = *(const PG8_GAS f32x4*)(cs + (size_t)s * 32 + 8 * fq), c1 = *(const PG8_GAS f32x4*)(cs + (size_t)s * 32 + 8 * fq + 4);
                    const f32x4 s0 = *(const PG8_GAS f32x4*)(sn + (size_t)s * 32 + 8 * fq), s1 = *(const PG8_GAS f32x4*)(sn + (size_t)s * 32 + 8 * fq + 4);
                    const f32x4 xa = acc[ai][0][m][0] * r, xb = acc[ai][0][m][1] * r, ya = acc[ai][1][m][0] * r, yb = acc[ai][1][m][1] * r;
                    PG8_GAS bf16_t* rowp = Q + (size_t)row * 3072 + head * 192 + 128 + 8 * fq;
                    *(PG8_GAS u32x4*)rowp = pack8(xa * c0 - ya * s0, xb * c1 - yb * s1);
                    *(PG8_GAS u32x4*)(rowp + 32) = pack8(xa * s0 + ya * c0, xb * s1 + yb * c1); }
        }
    }
};
struct EpiKV {
    static constexpr bool PERM = true, AFTER_DRAIN = false, ROWSCALE = true; static constexpr float INV_N = 1.f / 512;
    PG8_GAS bf16_t *KN, *V; const PG8_GAS float* SX;
    __device__ __forceinline__ void operator()(const f32x4 (&acc)[2][2][4][2], const Unit& u, int wr, int wc, int fr, int fq, const PG8_LAS float* rsl) const {
        const int row0 = u.pm * BM + wr * 64 + fr, col0 = u.pn * HALF + wc * 32 + 8 * fq;
#pragma unroll
        for (int ai = 0; ai < 2; ++ai)
#pragma unroll
            for (int m = 0; m < 4; ++m) { const int row = row0 + ai * HALF + m * 16; const float r = rsl[ai * 64 + m * 16 + fr];
                *(PG8_GAS u32x4*)(KN + (size_t)row * 2048 + col0) = pack8(acc[ai][0][m][0] * r, acc[ai][0][m][1] * r);
                *(PG8_GAS u32x4*)(V + (size_t)row * 2048 + col0) = pack8(acc[ai][1][m][0] * r, acc[ai][1][m][1] * r); }
    }
};
template <int MODE> struct EpiGate {
    static constexpr bool PERM = true, AFTER_DRAIN = false, ROWSCALE = false;
    PG8_GAS bf16_t* O; const PG8_GAS bf16_t* G; const PG8_GAS bf16_t* P; int ldc;
    __device__ __forceinline__ void operator()(const f32x4 (&acc)[2][2][4][2], const Unit& u, int wr, int wc, int fr, int fq) const {
        const int row0 = u.pm * BM + wr * 64 + fr, col0 = u.pn * BM + wc * 32 + 8 * fq;
#pragma unroll
        for (int ai = 0; ai < 2; ++ai) {
            u32x4 gin[4][2], pin[4][2];
            if (MODE >= 1) {
#pragma unroll
                for (int m = 0; m < 4; ++m)
#pragma unroll
                    for (int bj = 0; bj < 2; ++bj) { const size_t off = (size_t)(row0 + ai * HALF + m * 16) * ldc + col0 + bj * HALF;
                        gin[m][bj] = *(const PG8_GAS u32x4*)(G + off); if (MODE == 2) pin[m][bj] = *(const PG8_GAS u32x4*)(P + off); }
            }
#pragma unroll
            for (int m = 0; m < 4; ++m)
#pragma unroll
                for (int bj = 0; bj < 2; ++bj) { const size_t off = (size_t)(row0 + ai * HALF + m * 16) * ldc + col0 + bj * HALF; f32x4 v0 = acc[ai][bj][m][0], v1 = acc[ai][bj][m][1];
                    if (MODE >= 1) { f32x4 g0, g1; unpack8(gin[m][bj], g0, g1); v0 = v0 * g0; v1 = v1 * g1; }
                    if (MODE == 2) { f32x4 p0, p1; unpack8(pin[m][bj], p0, p1); v0 = v0 + p0; v1 = v1 + p1; }
                    *(PG8_GAS u32x4*)(O + off) = pack8(v0, v1); }
        }
    }
};
template <bool HALF_ALPHA> struct EpiResid {
    static constexpr bool PERM = true, AFTER_DRAIN = false, ROWSCALE = false;
    PG8_GAS bf16_t* X; PG8_GAS float* SX;
    __device__ __forceinline__ void operator()(const f32x4 (&acc)[2][2][4][2], const Unit& u, int wr, int wc, int fr, int fq) const {
        const int row0 = u.pm * BM + wr * 64 + fr, col0 = u.pn * BM + wc * 32 + 8 * fq; const float alpha = HALF_ALPHA ? 0.5f : 1.0f;
        u32x4 xin[2][4][2];
#pragma unroll
        for (int ai = 0; ai < 2; ++ai)
#pragma unroll
            for (int m = 0; m < 4; ++m)
#pragma unroll
                for (int bj = 0; bj < 2; ++bj) xin[ai][m][bj] = *(const PG8_GAS u32x4*)(X + (size_t)(row0 + ai * HALF + m * 16) * 4096 + col0 + bj * HALF);
#pragma unroll
        for (int ai = 0; ai < 2; ++ai)
#pragma unroll
            for (int m = 0; m < 4; ++m) { const int row = row0 + ai * HALF + m * 16; const size_t off = (size_t)row * 4096 + col0; float s = 0.f;
#pragma unroll
                for (int bj = 0; bj < 2; ++bj) { f32x4 x0, x1; unpack8(xin[ai][m][bj], x0, x1);
                    const f32x4 v0 = x0 + acc[ai][bj][m][0] * alpha, v1 = x1 + acc[ai][bj][m][1] * alpha; s += ssq44(v0, v1);
                    *(PG8_GAS u32x4*)(X + off + bj * HALF) = pack8(v0, v1); }
                s = row4_sum(s); if (fq == 0) atomic_add_row(SX + row, s); }
    }
};
struct EpiPleGate {
    static constexpr bool PERM = true, AFTER_DRAIN = false, ROWSCALE = true; static constexpr float INV_N = 1.f / 4096;
    PG8_GAS bf16_t* TT; const PG8_GAS bf16_t* PP; int ldc; PG8_GAS float* sst; const PG8_GAS float* SX;
    __device__ __forceinline__ void operator()(const f32x4 (&acc)[2][2][4][2], const Unit& u, int wr, int wc, int fr, int fq, const PG8_LAS float* rsl) const {
        const int row0 = u.pm * BM + wr * 64 + fr, col0 = u.pn * BM + wc * 32 + 8 * fq;
        u32x4 pin[2][4][2];
#pragma unroll
        for (int ai = 0; ai < 2; ++ai)
#pragma unroll
            for (int m = 0; m < 4; ++m)
#pragma unroll
                for (int bj = 0; bj < 2; ++bj) pin[ai][m][bj] = *(const PG8_GAS u32x4*)(PP + (size_t)(row0 + ai * HALF + m * 16) * ldc + col0 + bj * HALF);
#pragma unroll
        for (int ai = 0; ai < 2; ++ai)
#pragma unroll
            for (int m = 0; m < 4; ++m) { const int row = row0 + ai * HALF + m * 16; const size_t off = (size_t)row * ldc + col0; float s = 0.f; const float r = rsl[ai * 64 + m * 16 + fr];
#pragma unroll
                for (int bj = 0; bj < 2; ++bj) { f32x4 p0, p1; unpack8(pin[ai][m][bj], p0, p1);
                    const f32x4 t0 = sigmoid4(acc[ai][bj][m][0] * r) * p0, t1 = sigmoid4(acc[ai][bj][m][1] * r) * p1;
                    s += ssq44(t0, t1);
                    *(PG8_GAS u32x4*)(TT + off + bj * HALF) = pack8(t0, t1); }
                s = row4_sum(s); if (fq == 0) atomic_add_row(sst + row, s); }
    }
};

template <class Epi, class Sched, bool ALIGN_EPI = false, bool SP2 = false>
__device__ __forceinline__ void gemm_phase(PG8_LAS unsigned char* lds, const Gemm g, const Sched& S, const Epi& E, const int tid) {
    const int wid = __builtin_amdgcn_readfirstlane(tid >> 6), lane = tid & 63, wr = wid >> 2, wc = wid & 3, fr = lane & 15, fq = lane >> 4;
    const int K = g.K, nt = K / BK;
    unsigned voffA[2], voffB[2];
#pragma unroll
    for (int i = 0; i < 2; ++i) { int R, C; stage_rc(tid * 16 + i * 8192, R, C); const int Rb = Epi::PERM ? ((R & ~31) + perm32(R & 31)) : R;
        voffA[i] = (unsigned)(R * K + C) * 2u; voffB[i] = (unsigned)(Rb * K + C) * 2u; }
    const size_t kstep = (size_t)(BK * 2);
    const size_t hstep = (size_t)HALF * K * 2;
    const size_t tstep = 2 * hstep;
    const unsigned ldsw = (unsigned)wid * 1024u;
    const int aoff = lds_byte(wr * 64 + fr, fq * 8), boff = lds_byte(wc * 32 + fr, fq * 8);
#define PG8_SA(b, h) (((b) * 2 + (h)) * HTB)
#define PG8_SB(b, h) ((4 + (b) * 2 + (h)) * HTB)
#define PG8_STAGE(bufoff, gbase, voff) do { _Pragma("unroll") for (int _i = 0; _i < 2; ++_i) \
        __builtin_amdgcn_global_load_lds((const PG8_GAS unsigned*)((const PG8_GAS char*)(gbase) + (voff)[_i]), (PG8_LAS unsigned*)(lds + (bufoff) + ldsw + _i * 8192), 16, 0, 0); } while (0)
#define PG8_LDA(dst, b, h) do { _Pragma("unroll") for (int m = 0; m < 4; ++m) _Pragma("unroll") for (int k = 0; k < 2; ++k) dst[m][k] = *(const PG8_LAS bf16x8*)(lds + PG8_SA(b, h) + aoff + m * 2048 + k * 1024); } while (0)
#define PG8_LDB(dst, b, h) do { _Pragma("unroll") for (int n = 0; n < 2; ++n) _Pragma("unroll") for (int k = 0; k < 2; ++k) dst[n][k] = *(const PG8_LAS bf16x8*)(lds + PG8_SB(b, h) + boff + n * 2048 + k * 1024); } while (0)
#define PG8_MMA(ai, bj, At, Bt) do { __builtin_amdgcn_s_setprio(1); _Pragma("unroll") for (int m = 0; m < 4; ++m) _Pragma("unroll") for (int n = 0; n < 2; ++n) _Pragma("unroll") for (int k = 0; k < 2; ++k) \
        acc[ai][bj][m][n] = __builtin_amdgcn_mfma_f32_16x16x32_bf16(Bt[n][k], At[m][k], acc[ai][bj][m][n], 0, 0, 0); __builtin_amdgcn_s_setprio(0); } while (0)
#define PG8_WAIT_V(n) asm volatile("s_waitcnt vmcnt(" #n ")" ::: "memory")
#define PG8_WAIT_L(n) asm volatile("s_waitcnt lgkmcnt(" #n ")" ::: "memory")
#define PG8_BAR __builtin_amdgcn_s_barrier()
#define PG8_SCHED __builtin_amdgcn_sched_barrier(0)
    Unit cur, nxt; int ui = 0; int rs_tag = -1;
    if (!S.next(0, cur)) return;
    f32x4 acc[2][2][4][2];
#pragma unroll
    for (int a = 0; a < 2; ++a)
#pragma unroll
        for (int b = 0; b < 2; ++b)
#pragma unroll
            for (int m = 0; m < 4; ++m)
#pragma unroll
                for (int n = 0; n < 2; ++n) acc[a][b][m][n] = (f32x4){0.f, 0.f, 0.f, 0.f};
    bf16x8 At[4][2], B0[2][2], B1[2][2];
    const PG8_GAS char* cA = (const PG8_GAS char*)g.A + (size_t)cur.pm * tstep; const PG8_GAS char* cB = (const PG8_GAS char*)g.Bt + (size_t)cur.pn * tstep;
    S.a_ready(cur);
    if constexpr (SP2) {
        PG8_STAGE(PG8_SB(0, 0), cB, voffB); PG8_STAGE(PG8_SB(0, 1), cB + hstep, voffB); PG8_STAGE(PG8_SA(0, 0), cA, voffA); PG8_STAGE(PG8_SA(0, 1), cA + hstep, voffA);
        if (wr == 1) PG8_BAR;
        PG8_WAIT_V(2); PG8_BAR;
        PG8_STAGE(PG8_SB(1, 0), cB + kstep, voffB); PG8_STAGE(PG8_SA(1, 0), cA + kstep, voffA); PG8_STAGE(PG8_SB(1, 1), cB + hstep + kstep, voffB);
        PG8_WAIT_V(6); PG8_BAR;
    } else {
        PG8_STAGE(PG8_SB(0, 0), cB, voffB); PG8_STAGE(PG8_SA(0, 0), cA, voffA); PG8_STAGE(PG8_SB(0, 1), cB + hstep, voffB); PG8_STAGE(PG8_SA(0, 1), cA + hstep, voffA);
        if (wr == 1) PG8_BAR;
        PG8_WAIT_V(4); PG8_BAR;
        PG8_STAGE(PG8_SB(1, 0), cB + kstep, voffB); PG8_STAGE(PG8_SA(1, 0), cA + kstep, voffA); PG8_STAGE(PG8_SB(1, 1), cB + hstep + kstep, voffB);
        PG8_WAIT_V(6); PG8_BAR;
    }
    for (;;) {
        const bool has_next = S.next(ui + 1, nxt);
        const PG8_GAS char* nA = has_next ? (const PG8_GAS char*)g.A + (size_t)nxt.pm * tstep : cA; const PG8_GAS char* nB = has_next ? (const PG8_GAS char*)g.Bt + (size_t)nxt.pn * tstep : cB;
        for (int t = 0; t < nt; t += 2) {
            const bool last = (t == nt - 2);
            const PG8_GAS char* a1 = cA + (size_t)(t + 1) * kstep;
            const PG8_GAS char* a2 = last ? nA : cA + (size_t)(t + 2) * kstep; const PG8_GAS char* b2 = last ? nB : cB + (size_t)(t + 2) * kstep;
            const PG8_GAS char* a3 = a2 + kstep; const PG8_GAS char* b3 = b2 + kstep;
            if (last && has_next) S.a_ready(nxt);
            if constexpr (SP2) {
            PG8_LDB(B0, 0, 0); PG8_LDB(B1, 0, 1); PG8_SCHED; PG8_LDA(At, 0, 0); PG8_STAGE(PG8_SA(1, 1), a1 + hstep, voffA);
            PG8_WAIT_V(8); PG8_WAIT_L(0); PG8_BAR; PG8_MMA(0, 0, At, B0); PG8_MMA(0, 1, At, B1); PG8_BAR; PG8_SCHED;
            PG8_LDA(At, 0, 1); PG8_STAGE(PG8_SB(0, 0), b2, voffB); PG8_STAGE(PG8_SB(0, 1), b2 + hstep, voffB); PG8_STAGE(PG8_SA(0, 0), a2, voffA);
            PG8_WAIT_V(8); PG8_WAIT_L(0); PG8_BAR; PG8_MMA(1, 0, At, B0); PG8_MMA(1, 1, At, B1); PG8_BAR; PG8_SCHED;
            PG8_LDB(B0, 1, 0); PG8_LDB(B1, 1, 1); PG8_SCHED; PG8_LDA(At, 1, 0); PG8_STAGE(PG8_SA(0, 1), a2 + hstep, voffA);
            PG8_WAIT_V(8); PG8_WAIT_L(0); PG8_BAR; PG8_MMA(0, 0, At, B0); PG8_MMA(0, 1, At, B1); PG8_BAR; PG8_SCHED;
            PG8_LDA(At, 1, 1); PG8_STAGE(PG8_SB(1, 0), b3, voffB); PG8_STAGE(PG8_SB(1, 1), b3 + hstep, voffB); PG8_STAGE(PG8_SA(1, 0), a3, voffA);
            PG8_WAIT_V(8); PG8_WAIT_L(0); PG8_BAR; PG8_MMA(1, 0, At, B0); PG8_MMA(1, 1, At, B1); PG8_BAR; PG8_SCHED;
            } else {
            PG8_LDB(B0, 0, 0); PG8_SCHED; PG8_LDA(At, 0, 0); PG8_STAGE(PG8_SA(1, 1), a1 + hstep, voffA);
            PG8_WAIT_L(8); PG8_BAR; PG8_WAIT_L(0); PG8_MMA(0, 0, At, B0); PG8_BAR; PG8_SCHED;
            PG8_LDB(B1, 0, 1); PG8_STAGE(PG8_SB(0, 0), b2, voffB);
            PG8_BAR; PG8_WAIT_L(0); PG8_MMA(0, 1, At, B1); PG8_BAR;
            PG8_LDA(At, 0, 1); PG8_STAGE(PG8_SA(0, 0), a2, voffA);
            PG8_BAR; PG8_WAIT_L(0); PG8_MMA(1, 0, At, B0); PG8_BAR; PG8_SCHED;
            PG8_STAGE(PG8_SB(0, 1), b2 + hstep, voffB);
            PG8_WAIT_V(6); PG8_BAR; PG8_MMA(1, 1, At, B1); PG8_BAR;
            PG8_LDB(B0, 1, 0); PG8_SCHED; PG8_LDA(At, 1, 0); PG8_STAGE(PG8_SA(0, 1), a2 + hstep, voffA);
            PG8_WAIT_L(8); PG8_BAR; PG8_WAIT_L(0); PG8_MMA(0, 0, At, B0); PG8_BAR; PG8_SCHED;
            PG8_LDB(B1, 1, 1); PG8_STAGE(PG8_SB(1, 0), b3, voffB);
            PG8_BAR; PG8_WAIT_L(0); PG8_MMA(0, 1, At, B1); PG8_BAR;
            PG8_LDA(At, 1, 1); PG8_STAGE(PG8_SA(1, 0), a3, voffA);
            PG8_BAR; PG8_WAIT_L(0); PG8_MMA(1, 0, At, B0); PG8_BAR; PG8_SCHED;
            PG8_STAGE(PG8_SB(1, 1), b3 + hstep, voffB);
            PG8_WAIT_V(6); PG8_BAR; PG8_MMA(1, 1, At, B1); PG8_BAR;
            }
        }
        if constexpr (ALIGN_EPI) { if (wr == 0) PG8_BAR; }
        if constexpr (!Epi::AFTER_DRAIN) {
            if constexpr (Epi::ROWSCALE) {
                PG8_LAS float* rsl = (PG8_LAS float*)(lds + RS_OFF + wid * 512);
                if (cur.pm != rs_tag) { rs_tag = cur.pm; const int rb = cur.pm * BM + wr * 64 + lane; rsl[lane] = rstd_from_ss(E.SX[rb], Epi::INV_N); rsl[64 + lane] = rstd_from_ss(E.SX[rb + HALF], Epi::INV_N); }
                E(acc, cur, wr, wc, fr, fq, rsl);
            } else E(acc, cur, wr, wc, fr, fq);
            S.done(cur); }
        if (!has_next) break;
#pragma unroll
        for (int a = 0; a < 2; ++a)
#pragma unroll
            for (int b = 0; b < 2; ++b)
#pragma unroll
                for (int m = 0; m < 4; ++m)
#pragma unroll
                    for (int n = 0; n < 2; ++n) acc[a][b][m][n] = (f32x4){0.f, 0.f, 0.f, 0.f};
        cur = nxt; cA = nA; cB = nB; ++ui;
        if constexpr (ALIGN_EPI) { if (wr == 1) PG8_BAR; }
    }
    PG8_WAIT_V(0);
    if constexpr (!ALIGN_EPI) { if (wr == 0) PG8_BAR; }
    PG8_BAR;
#undef PG8_SA
#undef PG8_SB
#undef PG8_STAGE
#undef PG8_LDA
#undef PG8_LDB
#undef PG8_MMA
#undef PG8_WAIT_V
#undef PG8_WAIT_L
#undef PG8_BAR
#undef PG8_SCHED
}
}

constexpr int NWAVES = 8;
constexpr int D = 4096, DFF = 11008, MROWS = 16384, NGRP = 2, PLE = 256, GMW = 2048, NH = 16, QLR = 1024, KVR = 512;
constexpr int INW = 13888, INWP = 14080, QW = 3072, KVW = 4096;
constexpr float EPS = 1e-6f;
constexpr size_t MiB = 1u << 20;
constexpr size_t WS_CTL = 0, CTL_ZERO_BYTES = 1152 * 1024;
constexpr size_t WS_COS = 2 * MiB, WS_SIN = 3 * MiB, WS_SS = 256 * 1024;
constexpr size_t WS_WF1U = 8 * MiB, WS_WF1D = WS_WF1U + 172 * MiB, WS_WF2U = WS_WF1D + 86 * MiB, WS_WF2D = WS_WF2U + 172 * MiB;
constexpr size_t WS_WIN = WS_WF2D + 86 * MiB, WS_WOA = WS_WIN + 110 * MiB, WS_WOB = WS_WOA + 16 * MiB, WS_WUQ = WS_WOB + 16 * MiB, WS_WUKV = WS_WUQ + 6 * MiB;
constexpr size_t WS_WO = WS_WUKV + 4 * MiB, WS_WPG = WS_WO + 32 * MiB, WS_WPP = WS_WPG + 32 * MiB, WS_WEND = WS_WPP + 2 * MiB;
static_assert(WS_WEND == 742 * MiB, "weight map");
constexpr size_t WS_XN = 744 * MiB;
constexpr size_t WS_R1 = WS_XN + 256 * MiB;
constexpr size_t WS_H = WS_R1, WS_GU = WS_R1, WS_GV = WS_R1 + 64 * MiB, WS_QL = WS_R1 + 128 * MiB, WS_KVL = WS_R1 + 160 * MiB, WS_KR = WS_R1 + 176 * MiB;
constexpr size_t WS_GA = WS_R1 + 192 * MiB, WS_GB = WS_R1 + 320 * MiB, WS_PP = WS_R1, WS_TT = WS_R1 + 256 * MiB;
constexpr size_t WS_Q = WS_R1 + 448 * MiB, WS_KN = WS_Q + 96 * MiB, WS_M1 = WS_GU, WS_MG = WS_KN, WS_V = WS_KN + 64 * MiB, WS_AO = WS_V + 64 * MiB, WS_GM = WS_AO + 64 * MiB;
constexpr size_t WS_PB = WS_R1 + 800 * MiB;
constexpr size_t WS_END = WS_PB + 16 * MiB;
static_assert((size_t)2 * MROWS * DFF * 2 <= 800 * MiB && WS_GM + 64 * MiB == WS_R1 + 800 * MiB && WS_END == 1816 * MiB, "activation map");
constexpr int CW_BAR = 4096, CW_XRANK = 12288;
constexpr size_t WS_SX = 640 * 1024;
constexpr size_t WS_SST = 65536;
constexpr int RING_OFF = 0, RING_BYTES = 131072;
constexpr int LDSCTL_OFF = RING_BYTES, MISC_OFF = LDSCTL_OFF + 320;
constexpr int LDS_BYTES = 147456;

#define GAS __attribute__((address_space(1)))
#define LAS __attribute__((address_space(3)))
typedef unsigned short bf16;
typedef unsigned v4u __attribute__((ext_vector_type(4)));
typedef unsigned v2u __attribute__((ext_vector_type(2)));
typedef float f32x4 __attribute__((ext_vector_type(4)));
typedef float f32x16 __attribute__((ext_vector_type(16)));
typedef short bf16x8 __attribute__((ext_vector_type(8)));
typedef short s16x4 __attribute__((ext_vector_type(4)));
typedef GAS unsigned gu32;
#define RLX_AGENT __ATOMIC_RELAXED, __HIP_MEMORY_SCOPE_AGENT
#define LDS_WAIT() asm volatile("s_waitcnt lgkmcnt(0)" ::: "memory")
#define VM_WAIT() asm volatile("s_waitcnt vmcnt(0)" ::: "memory")
__device__ __forceinline__ unsigned f2bf(float f) { unsigned u = __builtin_bit_cast(unsigned, f); return (u + 0x7fffu + ((u >> 16) & 1u)) >> 16; }
__device__ __forceinline__ unsigned pk2(float lo, float hi) { return pg8::cvt_pk_bf16(lo, hi); }

#define XB_TMO      128
#define XB_XCNT(j)  (256  + 64 * (j))
#define XB_XSUB(j)  (1280 + 64 * (j))
#define XB_XGEN(j)  (2304 + 64 * (j))
#define XB_TOP      3328
#define XB_TOPGEN   3392
#define XCD_BAR_WORDS 3456
#define XB_SPIN_CAP (1u << 20)
__device__ __forceinline__ unsigned xb_ld(unsigned* p)              { return __hip_atomic_load(p, __ATOMIC_RELAXED, __HIP_MEMORY_SCOPE_AGENT); }
__device__ __forceinline__ unsigned xb_add(unsigned* p, unsigned v) { return __hip_atomic_fetch_add(p, v, __ATOMIC_RELAXED, __HIP_MEMORY_SCOPE_AGENT); }
__device__ __forceinline__ unsigned xb_xcc_id() { return (unsigned)__builtin_amdgcn_s_getreg((3 << 11) | 20) & 0xFu; }
#define XB_SPIN(cond, bar) do { unsigned _sp = 0; while (cond) { __builtin_amdgcn_s_sleep(1); \
    if ((++_sp & 255u) == 0u) { if (xb_ld(&(bar)[XB_TMO])) break; if (_sp > XB_SPIN_CAP) { atomicAdd(&(bar)[XB_TMO], 1u); break; } } } } while (0)
struct XcdBarrier { unsigned* bar; unsigned x; volatile LAS unsigned* st; bool leader; };
__device__ __forceinline__ XcdBarrier xcd_barrier_post(unsigned* bar, volatile LAS unsigned* st, bool leader) {
    XcdBarrier b; b.bar = bar; b.x = xb_xcc_id(); b.st = st; b.leader = leader;
    if (leader) (void)xb_add(&bar[XB_XCNT(b.x)], 1u);
    return b;
}
__device__ __forceinline__ void xcd_barrier_complete(unsigned* bar, unsigned x, unsigned& nloc, unsigned& nx) {
    const unsigned G = gridDim.x * gridDim.y * gridDim.z;
    unsigned sum, cnt, mine, sp = 0u;
    for (;;) {
        sum = 0u; cnt = 0u; mine = 0u;
#pragma unroll
        for (unsigned j = 0; j < 16; ++j) { const unsigned c = xb_ld(&bar[XB_XCNT(j)]); sum += c; cnt += (c > 0u) ? 1u : 0u; mine = (j == x) ? c : mine; }
        if (sum == G) break;
        __builtin_amdgcn_s_sleep(1);
        if ((++sp & 255u) == 0u) { if (xb_ld(&bar[XB_TMO])) break; if (sp > XB_SPIN_CAP) { atomicAdd(&bar[XB_TMO], 1u); break; } }
    }
    nloc = mine > 0u ? mine : 1u; nx = cnt > 0u ? cnt : 1u;
}
__device__ __forceinline__ void xcd_barrier(const XcdBarrier& b) {
    asm volatile("s_waitcnt vmcnt(0)" ::: "memory");
    __syncthreads();
    if (b.leader) {
        unsigned* bar = b.bar;
        __builtin_amdgcn_s_waitcnt(0);
        unsigned nloc = b.st[0], nx = b.st[1];
        if (nloc == 0u) { xcd_barrier_complete(bar, b.x, nloc, nx); b.st[0] = nloc; b.st[1] = nx; }
        const unsigned old = xb_add(&bar[XB_XSUB(b.x)], 1u);
        const unsigned gen = old / nloc;
        if (old + 1u == (gen + 1u) * nloc) {
            __builtin_amdgcn_fence(__ATOMIC_RELEASE, "agent");
            asm volatile("s_waitcnt vmcnt(0)" ::: "memory");
            const unsigned og = xb_add(&bar[XB_TOP], 1u);
            const unsigned tg = og / nx;
            if (og + 1u == (tg + 1u) * nx) xb_add(&bar[XB_TOPGEN], 1u);
            else XB_SPIN(xb_ld(&bar[XB_TOPGEN]) == tg, bar);
            __builtin_amdgcn_fence(__ATOMIC_ACQUIRE, "agent");
            xb_add(&bar[XB_XGEN(b.x)], 1u);
            asm volatile("s_waitcnt vmcnt(0)" ::: "memory");
        } else {
            XB_SPIN(xb_ld(&bar[XB_XGEN(b.x)]) == gen, bar);
            __builtin_amdgcn_fence(__ATOMIC_ACQUIRE, "agent");
            asm volatile("s_waitcnt vmcnt(0)" ::: "memory");
        }
    }
    __syncthreads();
}

struct Args { const float* in[29]; float* out; unsigned char* ws; };
typedef GAS float gf32; typedef GAS unsigned short gbf16;
struct Frame {
    LAS unsigned char* lds;
    int tid, lane, wave, G, bid, gw, ngw;
    int xc, wx;
};
__device__ __forceinline__ float wave_sum(float v) {
    v += __int_as_float(__builtin_amdgcn_ds_swizzle(__float_as_int(v), (1 << 10) | 0x1f));
    v += __int_as_float(__builtin_amdgcn_ds_swizzle(__float_as_int(v), (2 << 10) | 0x1f));
    v += __int_as_float(__builtin_amdgcn_ds_swizzle(__float_as_int(v), (4 << 10) | 0x1f));
    v += __int_as_float(__builtin_amdgcn_ds_swizzle(__float_as_int(v), (8 << 10) | 0x1f));
    v += __int_as_float(__builtin_amdgcn_ds_swizzle(__float_as_int(v), (16 << 10) | 0x1f));
    auto rr = __builtin_amdgcn_permlane32_swap(__float_as_uint(v), __float_as_uint(v), false, false);
    return __uint_as_float(rr[0]) + __uint_as_float(rr[1]);
}

__device__ __forceinline__ void tr_item(const gf32* W, int ldw, int k0, int n0src, gbf16* WT, int K, int row0dst, const gf32* kscale, LAS float* scr, int lane) {
    f32x4 wv[8];
#pragma unroll
    for (int i = 0; i < 8; ++i) wv[i] = __builtin_nontemporal_load((const GAS f32x4*)(W + (size_t)(k0 + 8 * i + (lane >> 3)) * ldw + n0src + (lane & 7) * 4));
#pragma unroll
    for (int i = 0; i < 8; ++i) { LAS float* d = scr + (8 * i + (lane >> 3)) * 33 + (lane & 7) * 4; d[0] = wv[i].x; d[1] = wv[i].y; d[2] = wv[i].z; d[3] = wv[i].w; }
    LDS_WAIT(); asm volatile("" ::: "memory");
    const int c = lane & 7;
    f32x4 ka = (f32x4){1.f, 1.f, 1.f, 1.f}, kb = ka;
    if (kscale) { ka = *(const GAS f32x4*)(kscale + k0 + 8 * c); kb = *(const GAS f32x4*)(kscale + k0 + 8 * c + 4); }
#pragma unroll
    for (int j = 0; j < 4; ++j) { const int n = (lane >> 3) + 8 * j; const LAS float* s = scr + (8 * c) * 33 + n;
        v4u o; o.x = pk2(s[0 * 33] * ka.x, s[1 * 33] * ka.y); o.y = pk2(s[2 * 33] * ka.z, s[3 * 33] * ka.w); o.z = pk2(s[4 * 33] * kb.x, s[5 * 33] * kb.y); o.w = pk2(s[6 * 33] * kb.z, s[7 * 33] * kb.w);
        *(GAS v4u*)(WT + (size_t)(row0dst + n) * K + k0 + 8 * c) = o; }
    LDS_WAIT(); asm volatile("" ::: "memory");
}
template <int MAP> __device__ __forceinline__ void tr_matrix(const Frame& F, const gf32* W, const gf32* W2, int ldw, int K, int NP, gbf16* WT, const gf32* kscale, LAS float* scr, int& base) {
    const int nkb = K / 64, nnb = NP / 32, nitems = nkb * nnb;
    int it = ((F.gw - base) % F.ngw + F.ngw) % F.ngw;
    for (; it < nitems; it += F.ngw) {
        const int nb = it / nkb, kb = it % nkb, n0 = nb * 32; const gf32* src = W; int c0 = n0;
        if (MAP == 1) { const int t = n0 >> 8, r = n0 & 255; src = (r >= 128) ? W2 : W; c0 = 128 * t + (r & 127); }
        if (MAP == 2) { const int t = n0 >> 8, r = n0 & 255; if (t < 22) c0 = n0; else if (t == 22) c0 = (r == 128) ? 5664 : 5632; else c0 = 5696 + (n0 - 23 * 256); }
        if (MAP == 3) { if (n0 < 2048) { const int t = n0 >> 8, bj = (n0 >> 7) & 1, jj = n0 & 127; c0 = (2 * t + bj) * 192 + jj; }
                        else { const int r = n0 - 2048, t = r >> 8, bj = (r >> 7) & 1, hh = (r >> 5) & 3; c0 = (4 * t + hh) * 192 + 128 + 32 * bj; } }
        tr_item(src, ldw, kb * 64, c0, WT, K, n0, kscale, scr, F.lane);
    }
    base = (base + nitems) % F.ngw;
}

__device__ __forceinline__ void row_to_bf16_ss(const gf32* xrow, gbf16* orow, gf32* ss, int lane) {
    const GAS f32x4* xr = (const GAS f32x4*)xrow + lane; GAS v2u* o8 = (GAS v2u*)orow + lane; float s = 0.f;
#pragma unroll
    for (int j = 0; j < 16; ++j) { const f32x4 v = __builtin_nontemporal_load(xr + 64 * j); s += (v.x * v.x + v.y * v.y) + (v.z * v.z + v.w * v.w); v2u w; w.x = pk2(v.x, v.y); w.y = pk2(v.z, v.w); o8[64 * j] = w; }
    s = wave_sum(s); if (lane == 0) *ss = s;
}
__device__ __forceinline__ float ssq8(const v4u w) {
    const float a = pg8::bf_lo(w.x), b = pg8::bf_hi(w.x), c = pg8::bf_lo(w.y), d = pg8::bf_hi(w.y), e = pg8::bf_lo(w.z), f = pg8::bf_hi(w.z), g = pg8::bf_lo(w.w), h = pg8::bf_hi(w.w);
    return ((a * a + b * b) + (c * c + d * d)) + ((e * e + f * f) + (g * g + h * h));
}

__device__ __forceinline__ void gmlp_phase(const Frame& F, const gf32* ws, const gf32* bs, const gf32* gvn, const gbf16* GU, const gbf16* GV, const gf32* RSV, gbf16* GM) {
    LAS unsigned char* As = F.lds;
    LAS unsigned char* Bs = F.lds + 34816;
    LAS float* rsl = (LAS float*)(F.lds + 69632);
    const int tid = F.tid, lane = F.lane, w = F.wave, fr = lane & 15, fq = lane >> 4;
    const int nitems = (MROWS / 128) * 16;
    (void)nitems;
    for (int k_ = 0; k_ < 8; ++k_) { const int ii = (F.bid >> 3) + 32 * k_;
        const int ch = 16 * F.xc + (ii >> 4), gg = ii & 15, row0 = ch * 128;
        if (tid < 128) rsl[tid] = pg8::rstd_from_ss(RSV[row0 + tid], 1.f / GMW);
        __syncthreads();
#pragma unroll
        for (int i = 0; i < 4; ++i) { const int c = tid + 512 * i, p = c >> 4, q8 = c & 15;
            const f32x4 w0 = *(const GAS f32x4*)(ws + ((size_t)(gg * 128 + p)) * 128 + q8 * 8), w1 = *(const GAS f32x4*)(ws + ((size_t)(gg * 128 + p)) * 128 + q8 * 8 + 4);
            const f32x4 r0 = *(const LAS f32x4*)(rsl + q8 * 8), r1 = *(const LAS f32x4*)(rsl + q8 * 8 + 4);
            *(LAS v4u*)(As + p * 272 + q8 * 16) = pg8::pack8(w0 * r0, w1 * r1); }
#pragma unroll
        for (int i = 0; i < 4; ++i) { const int c = tid + 512 * i, q = c >> 4, c8 = c & 15;
            const v4u v = *(const GAS v4u*)(GV + (size_t)(row0 + q) * GMW + gg * 128 + c8 * 8);
            const int qq = (q ^ (c8 << 3)) * 2; LAS unsigned char* bp = Bs + (c8 * 8) * 272 + qq;
            *(LAS unsigned short*)(bp + 0 * 272) = (unsigned short)(v.x & 0xffffu); *(LAS unsigned short*)(bp + 1 * 272) = (unsigned short)(v.x >> 16);
            *(LAS unsigned short*)(bp + 2 * 272) = (unsigned short)(v.y & 0xffffu); *(LAS unsigned short*)(bp + 3 * 272) = (unsigned short)(v.y >> 16);
            *(LAS unsigned short*)(bp + 4 * 272) = (unsigned short)(v.z & 0xffffu); *(LAS unsigned short*)(bp + 5 * 272) = (unsigned short)(v.z >> 16);
            *(LAS unsigned short*)(bp + 6 * 272) = (unsigned short)(v.w & 0xffffu); *(LAS unsigned short*)(bp + 7 * 272) = (unsigned short)(v.w >> 16); }
        __syncthreads();
        f32x4 acc[8];
#pragma unroll
        for (int ni = 0; ni < 8; ++ni) acc[ni] = (f32x4){0.f, 0.f, 0.f, 0.f};
#pragma unroll
        for (int kb = 0; kb < 4; ++kb) {
            const bf16x8 a = *(const LAS bf16x8*)(As + (16 * w + fr) * 272 + (kb * 32 + fq * 8) * 2);
#pragma unroll
            for (int ni = 0; ni < 8; ++ni) { const int cc = 16 * ni + fr, c8 = cc >> 3;
                const bf16x8 b = *(const LAS bf16x8*)(Bs + cc * 272 + (((kb * 32 + fq * 8) ^ (c8 << 3)) * 2));
                acc[ni] = __builtin_amdgcn_mfma_f32_16x16x32_bf16(b, a, acc[ni], 0, 0, 0); }
        }
        const int row = row0 + 16 * w + fr; const float bsv = bs[gg * 128 + 16 * w + fr];
#pragma unroll
        for (int ni = 0; ni < 8; ++ni) { const int c0 = gg * 128 + 16 * ni + 4 * fq;
            const v2u gu = *(const GAS v2u*)(GU + (size_t)row * GMW + c0); const f32x4 gn = *(const GAS f32x4*)(gvn + c0);
            const float o0 = pg8::bf_lo(gu.x) * (gn[0] * acc[ni][0] + bsv), o1 = pg8::bf_hi(gu.x) * (gn[1] * acc[ni][1] + bsv);
            const float o2 = pg8::bf_lo(gu.y) * (gn[2] * acc[ni][2] + bsv), o3 = pg8::bf_hi(gu.y) * (gn[3] * acc[ni][3] + bsv);
            v2u o; o.x = pg8::cvt_pk_bf16(o0, o1); o.y = pg8::cvt_pk_bf16(o2, o3);
            *(GAS v2u*)(GM + (size_t)row * GMW + c0) = o; }
        __syncthreads();
    }
}

namespace att {
constexpr float SCALE = 0.07216878364870322f;
constexpr float THR = 8.f;
constexpr int SHM_V = 16384, SHM_K = 24576;
constexpr int OFF_V = 0, OFF_K = 2 * SHM_V, OFF_S = OFF_K + 2 * SHM_K;
#define KSWZ(row, colB) ((row) * 384 + ((colB) ^ ((((row) >> 1) & 7) << 4)))
#define SBAR() __builtin_amdgcn_sched_barrier(0)
__device__ __forceinline__ int crow(int r, int hi) { return (r & 3) + 8 * (r >> 2) + 4 * hi; }
__device__ __forceinline__ unsigned cvtpk(float lo, float hi) { return pg8::cvt_pk_bf16(lo, hi); }
__device__ __forceinline__ void partialSM(f32x16& p0, f32x16& p1, float& m_reg, float& mn, float& alpha) {
    constexpr float C = SCALE * 1.4426950408889634f;
    float pmax = p0[0];
#pragma unroll
    for (int r = 1; r < 16; ++r) pmax = fmaxf(pmax, p0[r]);
#pragma unroll
    for (int r = 0; r < 16; ++r) pmax = fmaxf(pmax, p1[r]);
    { auto rr = __builtin_amdgcn_permlane32_swap(__float_as_uint(pmax), __float_as_uint(pmax), false, false);
      pmax = fmaxf(__uint_as_float(rr[0]), __uint_as_float(rr[1])); }
    if (__builtin_expect(__all(pmax - m_reg <= THR / SCALE), 1)) { mn = m_reg; alpha = 1.f; }
    else { mn = fmaxf(m_reg, pmax); alpha = __builtin_amdgcn_exp2f((m_reg - mn) * C); m_reg = mn; }
    const float mnC = -mn * C;
#pragma unroll
    for (int r = 0; r < 16; ++r) p0[r] = fmaf(p0[r], C, mnC);
#pragma unroll
    for (int r = 0; r < 16; ++r) p1[r] = fmaf(p1[r], C, mnC);
#pragma unroll
    for (int r = 0; r < 16; ++r) p0[r] = __builtin_amdgcn_exp2f(p0[r]);
}
__device__ __forceinline__ void finishSM(f32x16& p0, f32x16& p1, float alpha, float& l_reg, bf16x8& pa0, bf16x8& pa1, bf16x8& pa2, bf16x8& pa3) {
#pragma unroll
    for (int r = 0; r < 16; ++r) p1[r] = __builtin_amdgcn_exp2f(p1[r]);
    float ps = 0;
#pragma unroll
    for (int r = 0; r < 16; ++r) ps += p0[r];
#pragma unroll
    for (int r = 0; r < 16; ++r) ps += p1[r];
    { auto rr = __builtin_amdgcn_permlane32_swap(__float_as_uint(ps), __float_as_uint(ps), false, false);
      ps = __uint_as_float(rr[0]) + __uint_as_float(rr[1]); }
    l_reg = l_reg * alpha + ps;
#define PK4(P, BASE, OUT) do { unsigned a0 = cvtpk(P[BASE + 0], P[BASE + 1]), a1 = cvtpk(P[BASE + 2], P[BASE + 3]);   \
    unsigned b0 = cvtpk(P[BASE + 4], P[BASE + 5]), b1 = cvtpk(P[BASE + 6], P[BASE + 7]);                              \
    auto r0 = __builtin_amdgcn_permlane32_swap(a0, b0, false, false); auto r1 = __builtin_amdgcn_permlane32_swap(a1, b1, false, false); \
    v4u w = {r0[0], r1[0], r0[1], r1[1]}; OUT = __builtin_bit_cast(bf16x8, w); } while (0)
    PK4(p0, 0, pa0); PK4(p0, 8, pa1); PK4(p1, 0, pa2); PK4(p1, 8, pa3);
#undef PK4
}
__device__ __forceinline__ void qkt(f32x16& p0, f32x16& p1, const LAS unsigned char* Ks, const bf16x8 (&qr)[12], int r32, int hi) {
    p0 = f32x16{}; p1 = f32x16{};
    bf16x8 b0 = *(const LAS bf16x8*)(Ks + KSWZ(r32, (hi * 8) * 2)), b1 = *(const LAS bf16x8*)(Ks + KSWZ(32 + r32, (hi * 8) * 2));
#pragma unroll
    for (int d0 = 0; d0 < 12; ++d0) { const int cn = ((d0 + 1) * 16 + hi * 8) * 2; bf16x8 n0 = b0, n1 = b1;
        if (d0 < 11) { n0 = *(const LAS bf16x8*)(Ks + KSWZ(r32, cn)); n1 = *(const LAS bf16x8*)(Ks + KSWZ(32 + r32, cn)); }
        SBAR();
        p0 = __builtin_amdgcn_mfma_f32_32x32x16_bf16(b0, qr[d0], p0, 0, 0, 0);
        p1 = __builtin_amdgcn_mfma_f32_32x32x16_bf16(b1, qr[d0], p1, 0, 0, 0);
        SBAR();
        b0 = n0; b1 = n1; }
}
__device__ __forceinline__ int v_st(int k, int c) { const int kk = (k & ~0xC) | ((k & 4) << 1) | ((k & 8) >> 1); return ((kk >> 3) * 4 + (c >> 5)) * 512 + ((kk & 7) * 32 + (c & 31)) * 2; }
__device__ __forceinline__ int v_rd_base(int lane) { return ((lane & 3) << 3) | (((lane >> 2) & 3) << 6) | (((lane >> 4) & 1) << 5) | (((lane >> 5) & 1) << 8); }
constexpr int v_rd_off(int d0, int ks, int half) { return d0 * 512 + ks * 4096 + half * 2048; }
template <int OFF> __device__ __forceinline__ s16x4 tr_read(int vb) {
    s16x4 r; asm volatile("ds_read_b64_tr_b16 %0, %1 offset:%2" : "=&v"(r) : "v"(vb), "i"(OFF) : "memory"); return r;
}
__device__ __forceinline__ void pv_all(f32x16 (&o)[4], int vb, bf16x8 pa0, bf16x8 pa1, bf16x8 pa2, bf16x8 pa3) {
#define PK(L, H) (bf16x8){L[0], L[1], L[2], L[3], H[0], H[1], H[2], H[3]}
#define TRSET(S, D0) do { S##l0 = tr_read<v_rd_off(D0, 0, 0)>(vb); S##h0 = tr_read<v_rd_off(D0, 0, 1)>(vb); S##l1 = tr_read<v_rd_off(D0, 1, 0)>(vb); S##h1 = tr_read<v_rd_off(D0, 1, 1)>(vb); \
                          S##l2 = tr_read<v_rd_off(D0, 2, 0)>(vb); S##h2 = tr_read<v_rd_off(D0, 2, 1)>(vb); S##l3 = tr_read<v_rd_off(D0, 3, 0)>(vb); S##h3 = tr_read<v_rd_off(D0, 3, 1)>(vb); } while (0)
#define PVMMA(S, od) do { od = __builtin_amdgcn_mfma_f32_32x32x16_bf16(pa0, PK(S##l0, S##h0), od, 0, 0, 0); od = __builtin_amdgcn_mfma_f32_32x32x16_bf16(pa1, PK(S##l1, S##h1), od, 0, 0, 0); \
                          od = __builtin_amdgcn_mfma_f32_32x32x16_bf16(pa2, PK(S##l2, S##h2), od, 0, 0, 0); od = __builtin_amdgcn_mfma_f32_32x32x16_bf16(pa3, PK(S##l3, S##h3), od, 0, 0, 0); } while (0)
#define LWAIT(n) do { asm volatile("s_waitcnt lgkmcnt(" #n ")" ::: "memory"); SBAR(); } while (0)
    s16x4 Al0, Ah0, Al1, Ah1, Al2, Ah2, Al3, Ah3, Bl0, Bh0, Bl1, Bh1, Bl2, Bh2, Bl3, Bh3;
    TRSET(A, 0); TRSET(B, 1); LWAIT(8); PVMMA(A, o[0]); SBAR();
    TRSET(A, 2); LWAIT(8); PVMMA(B, o[1]); SBAR();
    TRSET(B, 3); LWAIT(8); PVMMA(A, o[2]); SBAR();
    LWAIT(0); PVMMA(B, o[3]);
#undef PK
#undef TRSET
#undef PVMMA
#undef LWAIT
}
__device__ __forceinline__ void attn_unit(const gbf16* Qb, const gbf16* Kh, const gbf16* Rh, const gbf16* Vh, gbf16* Ob, int seq, LAS unsigned char* lds, int tid) {
    constexpr int LDQ = 3072, LDK = 2048, LDR = 64, LDO = 2048;
    const int wid = tid >> 6, lane = tid & 63, r32 = lane & 31, hi = lane >> 5;
    LAS unsigned char* V_lds = lds + OFF_V; LAS unsigned char* K_lds = lds + OFF_K;
    LAS float* wsf = (LAS float*)(lds + OFF_S) + wid * 64; LAS float* li_l = wsf; LAS float* al_l = wsf + 32;
    float m_reg = -1e30f, l_reg = 0.f; f32x16 o[4] = {}; bf16x8 qr[12];
    const GAS bf16* Qw = Qb + (size_t)(wid * 32 + r32) * LDQ + hi * 8;
#pragma unroll
    for (int d0 = 0; d0 < 12; ++d0) qr[d0] = *(const GAS bf16x8*)(Qw + d0 * 16);
    const int sr = tid >> 4, sc = (tid & 15) * 8, vst0 = v_st(sr, sc), vst1 = v_st(32 + sr, sc);
    const int rr = tid >> 3, rc = (tid & 7) * 8;
    const int vb0 = (int)(unsigned)(uintptr_t)V_lds + v_rd_base(lane);
    bf16x8 vs0, vs1, ks0, ks1, ks2;
    const unsigned vo_kv = (unsigned)(sr * LDK + sc) * 2u, vo_r = (unsigned)(rr * LDR + rc) * 2u;
#define SLOADK(k0) do { const GAS char* kb_ = (const GAS char*)Kh + (size_t)(k0) * (LDK * 2); const GAS char* rb_ = (const GAS char*)Rh + (size_t)(k0) * (LDR * 2); \
    unsigned o1_ = vo_kv, o2_ = vo_r; asm volatile("" : "+v"(o1_), "+v"(o2_));     \
    ks0 = *(const GAS bf16x8*)(kb_ + o1_); ks1 = *(const GAS bf16x8*)(kb_ + 32 * LDK * 2 + o1_); ks2 = *(const GAS bf16x8*)(rb_ + o2_); } while (0)
#define SLOADV(k0) do { const GAS char* vb_ = (const GAS char*)Vh + (size_t)(k0) * (LDK * 2); unsigned o1_ = vo_kv; asm volatile("" : "+v"(o1_)); \
    vs0 = *(const GAS bf16x8*)(vb_ + o1_); vs1 = *(const GAS bf16x8*)(vb_ + 32 * LDK * 2 + o1_); } while (0)
#define SWRITEK(b) do { *(LAS bf16x8*)(K_lds + (b) * SHM_K + KSWZ(sr, sc * 2)) = ks0; *(LAS bf16x8*)(K_lds + (b) * SHM_K + KSWZ(32 + sr, sc * 2)) = ks1; \
    *(LAS bf16x8*)(K_lds + (b) * SHM_K + KSWZ(rr, 256 + rc * 2)) = ks2; } while (0)
#define SWRITEV(b) do { *(LAS bf16x8*)(V_lds + (b) * SHM_V + vst0) = vs0; *(LAS bf16x8*)(V_lds + (b) * SHM_V + vst1) = vs1; } while (0)
    const int NT = seq / 64, grp = __builtin_amdgcn_readfirstlane(wid >> 2);
    SLOADK(0); SWRITEK(0);
    SLOADK(64); SLOADV(0);
    f32x16 p0, p1; float mn, al; bf16x8 pa0, pa1, pa2, pa3;
#define ST_BAR() do { LDS_WAIT(); __builtin_amdgcn_s_barrier(); asm volatile("" ::: "memory"); } while (0)
#define ST_WRITES(j) do { if ((j) + 1 < NT) SWRITEK(((j) + 1) & 1); SWRITEV((j) & 1); if ((j) + 2 < NT) SLOADK(((j) + 2) * 64); if ((j) + 1 < NT) SLOADV(((j) + 1) * 64); } while (0)
#define ST_PV(j) do { const int vb = vb0 + ((j) & 1) * SHM_V; SBAR(); \
        pv_all(o, vb, pa0, pa1, pa2, pa3); } while (0)
#define ST_QK(j) do { SBAR(); qkt(p0, p1, K_lds + ((j) & 1) * SHM_K, qr, r32, hi); } while (0)
#define ST_SM() do { partialSM(p0, p1, m_reg, mn, al); \
        if (__any(al < 1.f)) { if (hi == 0) al_l[r32] = al; LDS_WAIT(); \
            _Pragma("unroll") for (int d = 0; d < 4; ++d) _Pragma("unroll") for (int r = 0; r < 16; ++r) o[d][r] *= al_l[crow(r, hi)]; } \
        finishSM(p0, p1, al, l_reg, pa0, pa1, pa2, pa3); SBAR(); } while (0)
    if (grp == 0) {
        ST_BAR(); ST_QK(0); ST_BAR(); ST_WRITES(0); ST_SM();
        for (int j = 1; j < NT; ++j) { ST_BAR(); ST_PV(j - 1); ST_QK(j); ST_BAR(); ST_WRITES(j); ST_SM(); }
        ST_BAR(); ST_PV(NT - 1); ST_BAR();
    } else {
        ST_BAR(); ST_BAR(); ST_WRITES(0); ST_QK(0); ST_BAR(); ST_SM();
        for (int j = 1; j < NT; ++j) { ST_BAR(); ST_WRITES(j); ST_PV(j - 1); ST_QK(j); ST_BAR(); ST_SM(); }
        ST_BAR(); ST_PV(NT - 1);
    }
#undef ST_BAR
#undef ST_WRITES
#undef ST_PV
#undef ST_QK
#undef ST_SM
    if (hi == 0) li_l[r32] = l_reg; LDS_WAIT();
    float rli[16];
#pragma unroll
    for (int r = 0; r < 16; ++r) rli[r] = __builtin_amdgcn_rcpf(li_l[crow(r, hi)]);
    GAS bf16* Ow = Ob + (size_t)(wid * 32) * LDO;
#pragma unroll
    for (int r = 0; r < 16; ++r) { const int orow = crow(r, hi);
#pragma unroll
        for (int d0 = 0; d0 < 4; ++d0) Ow[(size_t)orow * LDO + d0 * 32 + r32] = (bf16)f2bf(o[d0][r] * rli[r]); }
    LDS_WAIT();
#undef SLOADK
#undef SLOADV
#undef SWRITEK
#undef SWRITEV
}
#undef KSWZ
}

__device__ __forceinline__ void attn_phase(const Frame& F, const gbf16* Q, const gbf16* KN, const gbf16* KR, const gbf16* V, gbf16* AO, int S) {
    for (int k_ = 0; k_ < 4; ++k_) {
        const int ii = (F.bid >> 3) + 32 * k_, h = ii >> 3, r0 = F.xc * 2048 + (ii & 7) * 256, b = r0 / S, qb = (r0 % S) >> 8; const size_t rb = (size_t)b * S;
        att::attn_unit(Q + (rb + (size_t)qb * 256) * 3072 + h * 192, KN + rb * 2048 + h * 128, KR + rb * 64, V + rb * 2048 + h * 128,
                       AO + (rb + (size_t)qb * 256) * 2048 + h * 128, S, F.lds, F.tid);
    }
}

__device__ __forceinline__ int lane_now() { int ln; asm volatile("v_mbcnt_lo_u32_b32 %0, -1, 0\n\tv_mbcnt_hi_u32_b32 %0, -1, %0" : "=v"(ln)); return ln; }
__device__ __forceinline__ int opq(int k) { asm volatile("" : "+s"(k)); return k; }
__device__ __forceinline__ unsigned char* opqp(unsigned char* p) { asm volatile("" : "+s"(p)); return p; }
__device__ __forceinline__ const gf32* opqg(const gf32* p) { asm volatile("" : "+s"(p)); return p; }
__device__ __forceinline__ unsigned* opqu(unsigned* p) { asm volatile("" : "+s"(p)); return p; }
__device__ __forceinline__ Frame make_frame(LAS unsigned char* l, int wave_sgpr) {
    Frame F; int ln = lane_now(); int wv = wave_sgpr; asm volatile("" : "+s"(wv));
    int b = __builtin_amdgcn_readfirstlane(*(volatile LAS int*)(l + MISC_OFF + 14 * 4)); asm volatile("" : "+s"(b)); int G = gridDim.x; asm volatile("" : "+s"(G));
    F.lds = l; F.tid = wv * 64 + ln; F.lane = ln; F.wave = wv; F.G = G; F.bid = b; F.gw = b * NWAVES + wv; F.ngw = G * NWAVES; F.xc = b & 7; F.wx = (b >> 3) * NWAVES + wv; return F; }
#define INP(k) ((const gf32*)args.in[opq(k)])
#define WSP(T, off) ((GAS T*)(w_ + (off)))
#define GEMM_PHASE_MW(EPI, Wgm, Mrows, Aptr, Bptr, Ncols, Kdim, ...) do { pg8::Gemm gm_{Aptr, Bptr, Mrows, Ncols, Kdim}; pg8::StaticOrder So_; So_.init(Mrows, Ncols, F.G, F.bid, Wgm); EPI E_{__VA_ARGS__}; \
    pg8::gemm_phase<EPI, pg8::StaticOrder, true, true>(F.lds + RING_OFF, gm_, So_, E_, F.tid); } while (0)
#define GEMM_PHASE_M(EPI, ...) GEMM_PHASE_MW(EPI, 8, __VA_ARGS__)
#define GEMM_PHASE(EPI, ...) GEMM_PHASE_MW(EPI, 8, MROWS, __VA_ARGS__)
#define M2 (2 * MROWS)
#define PHASE_BEGIN() unsigned char* w_ = opqp(args.ws); const Frame F = make_frame((LAS unsigned char*)lds, wave_id)
#define FOR_ROWS2() _Pragma("unroll 1") for (int it_ = 0; it_ < 16; ++it_) if (const int gg_ = it_ >> 3, m_ = F.xc * 2048 + F.wx + 256 * (it_ & 7), mg_ = gg_ * MROWS + m_; true)


#define GRID_BAR() do { XcdBarrier b2_ = bar; b2_.bar = opqu(b2_.bar); b2_.x = (unsigned)opq((int)b2_.x); { int wv_ = wave_id; asm volatile("" : "+s"(wv_)); int ln_ = lane_now(); b2_.leader = (wv_ == 0 && ln_ == 0); } xcd_barrier(b2_); } while (0)
template <int g> __device__ __forceinline__ void mixer_program(const Args args, unsigned char* lds, const int wave_id, const XcdBarrier bar) {
#define XPTR() ((gf32*)(args.out + (size_t)g * MROWS * D))
#define XNG() (WSP(bf16, WS_XN) + (size_t)g * MROWS * D)
#define SEQ() (g ? 8192 : 2048)
#define SSG() ((gf32*)(w_ + WS_SS + (size_t)g * 196608))
#define SXG(j) ((gf32*)(w_ + WS_SX + (size_t)(j) * 131072 + (size_t)g * 65536))
        { PHASE_BEGIN();
            GEMM_PHASE(pg8::EpiZ, XNG(), WSP(bf16, WS_WIN), INWP, D, WSP(bf16, WS_GU), WSP(bf16, WS_GV), WSP(bf16, WS_QL), WSP(bf16, WS_KVL), WSP(bf16, WS_KR), WSP(bf16, WS_GA), WSP(bf16, WS_GB),
                       WSP(float, WS_COS), WSP(float, WS_SIN), SEQ() - 1, SSG(), SXG(1)); }
        GRID_BAR();
        { PHASE_BEGIN(); gmlp_phase(F, INP(11), INP(12), INP(10), WSP(bf16, WS_GU), WSP(bf16, WS_GV), SSG(), WSP(bf16, WS_GM)); }
        { PHASE_BEGIN(); GEMM_PHASE(pg8::EpiQ, WSP(bf16, WS_QL), WSP(bf16, WS_WUQ), QW, QLR, WSP(bf16, WS_Q), SSG() + 16384, WSP(float, WS_COS), WSP(float, WS_SIN), SEQ() - 1); }
        { PHASE_BEGIN(); GEMM_PHASE(pg8::EpiKV, WSP(bf16, WS_KVL), WSP(bf16, WS_WUKV), KVW, KVR, WSP(bf16, WS_KN), WSP(bf16, WS_V), SSG() + 32768); }
        GRID_BAR();
        { PHASE_BEGIN(); attn_phase(F, WSP(bf16, WS_Q), WSP(bf16, WS_KN), WSP(bf16, WS_KR), WSP(bf16, WS_V), WSP(bf16, WS_AO), SEQ()); }
        GRID_BAR();
        { PHASE_BEGIN(); GEMM_PHASE(pg8::EpiGate<1>, WSP(bf16, WS_GM), WSP(bf16, WS_WOA), D, GMW, WSP(bf16, WS_M1), WSP(bf16, WS_GA), nullptr, D); }
        { PHASE_BEGIN(); GEMM_PHASE(pg8::EpiGate<2>, WSP(bf16, WS_AO), WSP(bf16, WS_WOB), D, NH * 128, WSP(bf16, WS_MG), WSP(bf16, WS_GB), WSP(bf16, WS_M1), D); }
        GRID_BAR();
        { PHASE_BEGIN(); GEMM_PHASE(pg8::EpiResid<false>, WSP(bf16, WS_MG), WSP(bf16, WS_WO), D, D, XNG(), SXG(2)); }
#undef XPTR
#undef XNG
#undef SEQ
#undef SSG
#undef SXG
}

__device__ __forceinline__ void ffn1_program(const Args args, unsigned char* lds, const int wave_id, const XcdBarrier bar) {
        { PHASE_BEGIN(); GEMM_PHASE_M(pg8::EpiSwiGLU, M2, WSP(bf16, WS_XN), WSP(bf16, WS_WF1U), 2 * DFF, D, WSP(bf16, WS_H), DFF, (const gf32*)(w_ + WS_SX)); }
        GRID_BAR();
        { PHASE_BEGIN(); GEMM_PHASE_MW(pg8::EpiResid<true>, 2, M2, WSP(bf16, WS_H), WSP(bf16, WS_WF1D), D, DFF, WSP(bf16, WS_XN), (gf32*)(w_ + WS_SX + 131072)); }
        GRID_BAR();
}
__device__ __forceinline__ void tail_program(const Args args, unsigned char* lds, const int wave_id, const XcdBarrier bar) {
        { PHASE_BEGIN(); GEMM_PHASE_M(pg8::EpiSwiGLU, M2, WSP(bf16, WS_XN), WSP(bf16, WS_WF2U), 2 * DFF, D, WSP(bf16, WS_H), DFF, (const gf32*)(w_ + WS_SX + 2 * 131072)); }
        GRID_BAR();
        { PHASE_BEGIN(); GEMM_PHASE_MW(pg8::EpiResid<true>, 2, M2, WSP(bf16, WS_H), WSP(bf16, WS_WF2D), D, DFF, WSP(bf16, WS_XN), (gf32*)(w_ + WS_SX + 3 * 131072)); }
        GRID_BAR();
        { PHASE_BEGIN(); GEMM_PHASE_M(pg8::EpiGate<0>, M2, WSP(bf16, WS_PB), WSP(bf16, WS_WPP), D, opq(PLE), WSP(bf16, WS_PP), nullptr, nullptr, D); }
        { PHASE_BEGIN(); GEMM_PHASE_M(pg8::EpiPleGate, M2, WSP(bf16, WS_XN), WSP(bf16, WS_WPG), D, D, WSP(bf16, WS_TT), WSP(bf16, WS_PP), D, (GAS float*)(w_ + WS_SST), (const gf32*)(w_ + WS_SX + 3 * 131072)); }
        GRID_BAR();
        { PHASE_BEGIN(); gf32* X = (gf32*)args.out; const gbf16* XR = WSP(bf16, WS_XN); const gbf16* TT = WSP(bf16, WS_TT); const gf32* gp = INP(27); const gf32* gf = INP(28); const gf32* sst = (const gf32*)(w_ + WS_SST);
            FOR_ROWS2() { const int m = mg_;
                const GAS v2u* xr = (const GAS v2u*)(XR + (size_t)m * D) + F.lane; const GAS v2u* tr = (const GAS v2u*)(TT + (size_t)m * D) + F.lane;
                const GAS f32x4* g1 = (const GAS f32x4*)opqg(gp) + F.lane; const GAS f32x4* g2 = (const GAS f32x4*)opqg(gf) + F.lane;
                f32x4 xv[16]; const float rt = 1.0f / sqrtf(sst[m] * (1.f / D) + EPS); float sx = 0.f;
#pragma unroll
                for (int j = 0; j < 16; ++j) { const f32x4 gg = g1[64 * j]; const v2u tw = __builtin_nontemporal_load(tr + 64 * j); const f32x4 t = (f32x4){pg8::bf_lo(tw.x), pg8::bf_hi(tw.x), pg8::bf_lo(tw.y), pg8::bf_hi(tw.y)};
                    const v2u xq = __builtin_nontemporal_load(xr + 64 * j); xv[j] = (f32x4){pg8::bf_lo(xq.x), pg8::bf_hi(xq.x), pg8::bf_lo(xq.y), pg8::bf_hi(xq.y)} + t * rt * gg; sx += (xv[j].x * xv[j].x + xv[j].y * xv[j].y) + (xv[j].z * xv[j].z + xv[j].w * xv[j].w); }
                const float rx = 1.0f / sqrtf(wave_sum(sx) * (1.f / D) + EPS);
                GAS f32x4* orow = (GAS f32x4*)(X + (size_t)m * D) + F.lane;
#pragma unroll
                for (int j = 0; j < 16; ++j) { const f32x4 gg = g2[64 * j]; __builtin_nontemporal_store(xv[j] * rx * gg, orow + 64 * j); }
            } }
}

__global__ void __launch_bounds__(NWAVES * 64, 2) fwd(Args args) {
    extern __shared__ __attribute__((aligned(16))) unsigned char lds[];
    volatile LAS unsigned* MISC = (volatile LAS unsigned*)((LAS unsigned char*)lds + MISC_OFF);
    const int wave_id = __builtin_amdgcn_readfirstlane((int)threadIdx.x >> 6);
    { const int ln0 = lane_now();
      for (int u = wave_id * 64 + ln0; u < (LDS_BYTES - LDSCTL_OFF) / 4; u += NWAVES * 64) ((LAS unsigned*)((LAS unsigned char*)lds + LDSCTL_OFF))[u] = 0u; }
    __syncthreads();
    XcdBarrier bar = xcd_barrier_post((unsigned*)(args.ws + WS_CTL) + CW_BAR, MISC + 8, false);
    if (wave_id == 0 && lane_now() == 0) {
        (void)xb_add(&bar.bar[XB_XCNT(bar.x)], 1u);
        const unsigned rank = xb_add((unsigned*)(args.ws + WS_CTL) + CW_XRANK + 64 * (bar.x & 7u), 1u);
        MISC[12] = bar.x; MISC[13] = rank; MISC[14] = blockIdx.x;
    }
    __syncthreads();

    {
        unsigned char* w_ = opqp(args.ws); const Frame F = make_frame((LAS unsigned char*)lds, wave_id);
        LAS float* scr = (LAS float*)(F.lds + RING_OFF + F.wave * 16384);
        int base = 0;
        tr_matrix<1>(F, INP(5), INP(6), DFF, D, 2 * DFF, WSP(bf16, WS_WF1U), INP(4), scr, base);
        tr_matrix<0>(F, INP(7), nullptr, D, DFF, D, WSP(bf16, WS_WF1D), nullptr, scr, base);
        tr_matrix<1>(F, INP(21), INP(22), DFF, D, 2 * DFF, WSP(bf16, WS_WF2U), INP(20), scr, base);
        tr_matrix<0>(F, INP(23), nullptr, D, DFF, D, WSP(bf16, WS_WF2D), nullptr, scr, base);
        tr_matrix<2>(F, INP(9), nullptr, INW, D, INWP, WSP(bf16, WS_WIN), INP(8), scr, base);
        tr_matrix<0>(F, INP(13), nullptr, D, GMW, D, WSP(bf16, WS_WOA), nullptr, scr, base);
        tr_matrix<0>(F, INP(18), nullptr, D, NH * 128, D, WSP(bf16, WS_WOB), nullptr, scr, base);
        tr_matrix<3>(F, INP(15), nullptr, QW, QLR, QW, WSP(bf16, WS_WUQ), INP(14), scr, base);
        tr_matrix<0>(F, INP(17), nullptr, KVW, KVR, KVW, WSP(bf16, WS_WUKV), INP(16), scr, base);
        tr_matrix<0>(F, INP(19), nullptr, D, D, D, WSP(bf16, WS_WO), nullptr, scr, base);
        tr_matrix<0>(F, INP(25), nullptr, D, D, D, WSP(bf16, WS_WPG), INP(24), scr, base);
        tr_matrix<0>(F, INP(26), nullptr, D, PLE, D, WSP(bf16, WS_WPP), nullptr, scr, base);
        gf32* COS = WSP(float, WS_COS); gf32* SIN = WSP(float, WS_SIN);
        for (int i = F.bid * (NWAVES * 64) + F.tid; i < 8192 * 32; i += F.G * NWAVES * 64) {
            const int s = i >> 5, j = i & 31;
            const float inv = 1.0f / powf(10000.0f, (float)(2 * j) / 64.0f);
            const float ang = (float)s * inv;
            COS[i] = (float)cos((double)ang); SIN[i] = (float)sin((double)ang);
        }
        { const gf32* x0 = INP(0); const gf32* x1 = INP(1); const gf32* p0 = INP(2); const gf32* p1 = INP(3); gbf16* XR = WSP(bf16, WS_XN); gbf16* PB = WSP(bf16, WS_PB); gf32* SX0 = (gf32*)(w_ + WS_SX);
          FOR_ROWS2() { row_to_bf16_ss((gg_ ? x1 : x0) + (size_t)m_ * D, XR + (size_t)mg_ * D, SX0 + mg_, F.lane);
              const f32x4 pv = *((const GAS f32x4*)((gg_ ? p1 : p0) + (size_t)m_ * PLE) + F.lane); v2u w; w.x = pk2(pv.x, pv.y); w.y = pk2(pv.z, pv.w);
              *((GAS v2u*)(PB + (size_t)mg_ * PLE) + F.lane) = w; } }
    }
    GRID_BAR();
    if (wave_id == 0 && lane_now() == 0) {
        unsigned* cw = (unsigned*)(args.ws + WS_CTL) + CW_XRANK; bool ok = (gridDim.x == 256u);
        for (int j = 0; j < 8; ++j) ok = ok && (xb_ld(cw + 64 * j) == 32u);
        const unsigned x = MISC[12], rank = MISC[13];
        MISC[14] = (ok && x < 8u && rank < 32u) ? rank * 8u + x : blockIdx.x;
    }
    __syncthreads();


    ffn1_program(args, lds, wave_id, bar);
    mixer_program<0>(args, lds, wave_id, bar);
    mixer_program<1>(args, lds, wave_id, bar);
    GRID_BAR();
    tail_program(args, lds, wave_id, bar);
#undef GRID_BAR
}

extern "C" void kernel_launch(void* const* d_in, const int* in_sizes, int n_in, void* d_out, int out_size, void* d_ws, size_t ws_size, hipStream_t stream) {
    static int grid = 0;
    if (grid == 0) {
        if (n_in != 29 || in_sizes[0] != MROWS * D || out_size != 2 * MROWS * D || ws_size < WS_END) {
            fprintf(stderr, "kernel_launch: shape mismatch n_in %d in0 %d out %d ws %zu (need %zu)\n", n_in, n_in > 0 ? in_sizes[0] : -1, out_size, ws_size, (size_t)WS_END); grid = -1; return; }
        int dev = 0, cus = 0, per_cu = 0;
        if (hipGetDevice(&dev) != hipSuccess || hipDeviceGetAttribute(&cus, hipDeviceAttributeMultiprocessorCount, dev) != hipSuccess) { grid = -1; return; }
        if (hipFuncSetAttribute((const void*)fwd, hipFuncAttributeMaxDynamicSharedMemorySize, LDS_BYTES) != hipSuccess) { fprintf(stderr, "kernel_launch: hipFuncSetAttribute failed\n"); grid = -1; return; }
        if (hipOccupancyMaxActiveBlocksPerMultiprocessor(&per_cu, (const void*)fwd, NWAVES * 64, LDS_BYTES) != hipSuccess || per_cu < 1)
            fprintf(stderr, "kernel_launch: note: occupancy query reports %d workgroups per CU\n", per_cu);
        (void)hipGetLastError();
        if (cus != 256) { fprintf(stderr, "kernel_launch: built for 256 CUs (one workgroup per CU), device has %d; nothing launched\n", cus); grid = -1; return; }
        grid = cus;
    }
    if (grid < 0) return;
    if (hipMemsetAsync((char*)d_ws + WS_CTL, 0, CTL_ZERO_BYTES, stream) != hipSuccess) { fprintf(stderr, "kernel_launch: memset failed\n"); return; }
    Args a{};
    for (int i = 0; i < 29; ++i) a.in[i] = (const float*)d_in[i];
    a.out = (float*)d_out; a.ws = (unsigned char*)d_ws;
    hipLaunchKernelGGL(fwd, dim3(grid), dim3(NWAVES * 64), LDS_BYTES, stream, a);
    const hipError_t le = hipPeekAtLastError();
    if (le != hipSuccess) fprintf(stderr, "kernel_launch: launch failed: %s\n", hipGetErrorName(le));
}
```
